# Optimizing an MI355X kernel written in HIP

```python
import math
import jax, jax.numpy as jnp
from jax import lax
import numpy as np

D_MODEL = 2048
BATCH = 4
SEQ = 4096
DEPTH = 2

N_META = 16
BLOCK = 128
PAD = BLOCK - N_META

D_MIX = D_MODEL
ATTN_HEADS = 8
ATTN_HEAD_DIM = 64
D_ATTN = ATTN_HEADS * ATTN_HEAD_DIM
POOL_WINDOWS = (2, 4, 8, 16)
POOL_GROUPS = 4
D_POOL = 512
POOL_GROUP_DIM = D_POOL // POOL_GROUPS
D_SSD = D_MIX - D_ATTN - D_POOL
SSD_HEAD_DIM = 64
SSD_HEADS = D_SSD // SSD_HEAD_DIM
SSD_GROUPS = 2
SSD_HEADS_PER_GROUP = SSD_HEADS // SSD_GROUPS
SSD_STATE = 128
CONV_K = 4
D_CONV = D_SSD + 2 * SSD_GROUPS * SSD_STATE
SPLIT_SIZES = (D_ATTN, D_ATTN, D_ATTN, ATTN_HEADS, D_POOL, D_SSD, D_CONV, SSD_HEADS)
D_IN = sum(SPLIT_SIZES)
D_FF = 5632
ALPHA = (2 * DEPTH) ** 0.25
BETA = (8 * DEPTH) ** -0.25
LN_EPS = 1e-5
RMS_EPS = 1e-5
NEG_INF = -1e30

kernel_name = "hybrid_fox_pool_ssd_macaron_deepnorm"


def layer_norm(x, g, b):
    xf = x.astype(jnp.float32)
    mu = jnp.mean(xf, axis=-1, keepdims=True)
    var = jnp.mean(jnp.square(xf - mu), axis=-1, keepdims=True)
    return ((xf - mu) * lax.rsqrt(var + LN_EPS) * g + b).astype(x.dtype)


def swiglu(x, w_gate, w_up, w_down):
    return (jax.nn.silu(x @ w_gate) * (x @ w_up)) @ w_down


def pad_front(a):
    return jnp.pad(a, [(0, 0), (PAD, 0)] + [(0, 0)] * (a.ndim - 2))


def forgetting_attention(q, k, v, f_logit):
    b, l = q.shape[:2]
    lp = l + PAD
    nb = lp // BLOCK
    log_f = jax.nn.log_sigmoid(f_logit.astype(jnp.float32))
    c = jnp.cumsum(pad_front(log_f), axis=1).transpose(0, 2, 1)
    kf = pad_front(k).astype(jnp.float32)
    vf = pad_front(v).astype(jnp.float32)
    q_blocks = pad_front(q).astype(jnp.float32).reshape(
        b, nb, BLOCK, ATTN_HEADS, ATTN_HEAD_DIM).transpose(1, 0, 2, 3, 4)
    c_blocks = c.reshape(b, ATTN_HEADS, nb, BLOCK).transpose(2, 0, 1, 3)
    key_pos = jnp.arange(lp)
    scale = ATTN_HEAD_DIM ** -0.5

    def one_block(args):
        qb, cb, start = args
        s = jnp.einsum('bqhd,bkhd->bhqk', qb, kf) * scale
        s = s + cb[..., :, None] - c[:, :, None, :]
        q_pos = start + jnp.arange(BLOCK)
        mask = (key_pos[None, :] <= q_pos[:, None]) & (key_pos[None, :] >= PAD)
        p = jax.nn.softmax(jnp.where(mask, s, NEG_INF), axis=-1)
        return jnp.einsum('bhqk,bkhd->bqhd', p, vf)

    out = lax.map(one_block, (q_blocks, c_blocks, jnp.arange(nb) * BLOCK))
    out = out.transpose(1, 0, 2, 3, 4).reshape(b, lp, D_ATTN)[:, PAD:]
    return out.astype(q.dtype)


def multiscale_pool(u, pool_w, pool_scale):
    b, l, _ = u.shape
    uf = u.astype(jnp.float32).reshape(b, l, POOL_GROUPS, POOL_GROUP_DIM)
    cs0 = jnp.concatenate([jnp.zeros((b, 1, POOL_GROUPS, POOL_GROUP_DIM), jnp.float32),
                           jnp.cumsum(uf, axis=1)], axis=1)
    t = jnp.arange(l)
    means = []
    for g, w in enumerate(POOL_WINDOWS):
        upper = cs0[:, 1:, g]
        lower = jnp.concatenate([jnp.zeros((b, w - 1, POOL_GROUP_DIM), jnp.float32),
                                 cs0[:, :l + 1 - w, g]], axis=1)
        cnt = jnp.minimum(t + 1, w).astype(jnp.float32)
        means.append((upper - lower) / cnt[None, :, None])
    pooled = jnp.stack(means, axis=2)
    mixed = jnp.einsum('blgc,gcd->blgd', pooled - uf, pool_w)
    out = mixed.reshape(b, l, D_POOL) * pool_scale
    return out.astype(u.dtype)


def ssd_mixer(z, xbc, dt_raw, conv_w, conv_b, dt_bias, a_log, d_skip, norm_w):
    b, l, _ = z.shape
    lp = l + PAD
    nc = lp // BLOCK
    G, R, P, N = SSD_GROUPS, SSD_HEADS_PER_GROUP, SSD_HEAD_DIM, SSD_STATE
    xbc = lax.conv_general_dilated(xbc, conv_w[:, None, :], window_strides=(1,),
                                   padding=[(CONV_K - 1, 0)],
                                   dimension_numbers=('NWC', 'WIO', 'NWC'),
                                   feature_group_count=D_CONV) + conv_b
    xbc = jax.nn.silu(xbc.astype(jnp.float32))
    xs, bm, cm = jnp.split(xbc, [D_SSD, D_SSD + G * N], axis=-1)
    dt = jax.nn.softplus(dt_raw.astype(jnp.float32) + dt_bias)
    a = -jnp.exp(a_log.astype(jnp.float32)).reshape(G, R)
    xs = pad_front(xs).reshape(b, nc, BLOCK, G, R, P)
    bm = pad_front(bm).reshape(b, nc, BLOCK, G, N)
    cm = pad_front(cm).reshape(b, nc, BLOCK, G, N)
    dt_p = pad_front(dt).reshape(b, nc, BLOCK, G, R)
    x_dt = xs * dt_p[..., None]
    a_blk = (dt_p * a).transpose(0, 3, 4, 1, 2)
    a_cs = jnp.cumsum(a_blk, axis=-1)
    seg = a_cs[..., :, None] - a_cs[..., None, :]
    causal = jnp.tril(jnp.ones((BLOCK, BLOCK), dtype=bool))
    decay = jnp.exp(jnp.where(causal, seg, -jnp.inf))
    cb = jnp.einsum('bclgn,bcsgn->bgcls', cm, bm)
    y_diag = jnp.einsum('bgcls,bgrcls,bcsgrp->bclgrp', cb, decay, x_dt)
    decay_states = jnp.exp(a_cs[..., -1:] - a_cs)
    states = jnp.einsum('bclgn,bgrcl,bclgrp->bcgrpn', bm, decay_states, x_dt)
    chunk_decay = jnp.exp(a_cs[..., -1])

    def step(h, inp):
        s, d = inp
        return d[..., None, None] * h + s, h

    h0 = jnp.zeros((b, G, R, P, N), jnp.float32)
    _, prev = lax.scan(step, h0, (states.transpose(1, 0, 2, 3, 4, 5),
                                  chunk_decay.transpose(3, 0, 1, 2)))
    prev = prev.transpose(1, 0, 2, 3, 4, 5)
    y_off = jnp.einsum('bclgn,bcgrpn,bgrcl->bclgrp', cm, prev, jnp.exp(a_cs))
    y = y_diag + y_off + xs * d_skip.reshape(G, R)[..., None]
    y = y.reshape(b, lp, D_SSD)[:, PAD:]
    gy = (y * jax.nn.silu(z.astype(jnp.float32))).reshape(b, l, G, D_SSD // G)
    gy = gy * lax.rsqrt(jnp.mean(jnp.square(gy), axis=-1, keepdims=True) + RMS_EPS)
    return (gy.reshape(b, l, D_SSD) * norm_w).astype(z.dtype)


def hybrid_mixer(h, w_in, b_fgate, pool_w, pool_scale, conv_w, conv_b, dt_bias, a_log,
                 d_skip, ssd_norm_w, w_out):
    b, l, _ = h.shape
    proj = h @ w_in
    cuts = [int(v) for v in np.cumsum(SPLIT_SIZES)[:-1]]
    q, k, v, f_logit, u, z, xbc, dt_raw = jnp.split(proj, cuts, axis=-1)
    heads = (b, l, ATTN_HEADS, ATTN_HEAD_DIM)
    y_a = forgetting_attention(q.reshape(heads), k.reshape(heads), v.reshape(heads),
                               f_logit + b_fgate)
    y_b = multiscale_pool(u, pool_w, pool_scale)
    y_c = ssd_mixer(z, xbc, dt_raw, conv_w, conv_b, dt_bias, a_log, d_skip, ssd_norm_w)
    return jnp.concatenate([y_a, y_b, y_c], axis=-1) @ w_out


def setup_inputs(seed: int = 0) -> dict:
    key = jax.random.key(seed)
    ks = jax.random.split(key, 32)
    f32 = jnp.float32

    def nrm(i, shape, scale):
        return jax.random.normal(ks[i], shape, f32) * scale

    def gain(i, shape):
        return 1.0 + 0.02 * jax.random.normal(ks[i], shape, f32)

    D = D_MODEL
    dt0 = jnp.exp(jax.random.uniform(ks[13], (DEPTH, SSD_HEADS), f32)
                  * (math.log(0.1) - math.log(0.001)) + math.log(0.001))
    return {
        "x": nrm(0, (BATCH, SEQ, D), 1.0),
        "meta": nrm(1, (N_META, D), 1.0),
        "f1_gate": nrm(2, (DEPTH, D, D_FF), D ** -0.5),
        "f1_up": nrm(3, (DEPTH, D, D_FF), D ** -0.5),
        "f1_down": nrm(4, (DEPTH, D_FF, D), BETA * D_FF ** -0.5),
        "ln1_g": gain(5, (DEPTH, D)),
        "ln1_b": nrm(6, (DEPTH, D), 0.02),
        "w_in": nrm(7, (DEPTH, D, D_IN), D ** -0.5),
        "b_fgate": jax.random.uniform(ks[8], (DEPTH, ATTN_HEADS), f32, 1.0, 6.0),
        "pool_w": nrm(9, (DEPTH, POOL_GROUPS, POOL_GROUP_DIM, POOL_GROUP_DIM), POOL_GROUP_DIM ** -0.5),
        "pool_scale": gain(10, (DEPTH, D_POOL)),
        "conv_w": nrm(11, (DEPTH, CONV_K, D_CONV), CONV_K ** -0.5),
        "conv_b": nrm(12, (DEPTH, D_CONV), 0.02),
        "dt_bias": dt0 + jnp.log(-jnp.expm1(-dt0)),
        "a_log": jnp.log(jax.random.uniform(ks[14], (DEPTH, SSD_HEADS), f32, 1.0, 16.0)),
        "d_skip": gain(15, (DEPTH, SSD_HEADS)),
        "ssd_norm_w": gain(16, (DEPTH, D_SSD)),
        "w_out": nrm(17, (DEPTH, D_MIX, D), BETA * D_MIX ** -0.5),
        "ln2_g": gain(18, (DEPTH, D)),
        "ln2_b": nrm(19, (DEPTH, D), 0.02),
        "f2_gate": nrm(20, (DEPTH, D, D_FF), D ** -0.5),
        "f2_up": nrm(21, (DEPTH, D, D_FF), D ** -0.5),
        "f2_down": nrm(22, (DEPTH, D_FF, D), BETA * D_FF ** -0.5),
        "ln3_g": gain(23, (DEPTH, D)),
        "ln3_b": nrm(24, (DEPTH, D), 0.02),
    }


def reference(x, meta, f1_gate, f1_up, f1_down, ln1_g, ln1_b, w_in, b_fgate, pool_w,
              pool_scale, conv_w, conv_b, dt_bias, a_log, d_skip, ssd_norm_w, w_out,
              ln2_g, ln2_b, f2_gate, f2_up, f2_down, ln3_g, ln3_b):
    b = x.shape[0]
    h = jnp.concatenate([jnp.broadcast_to(meta[None].astype(x.dtype), (b, N_META, D_MODEL)), x],
                        axis=1)
    for i in range(DEPTH):
        h = layer_norm(ALPHA * h + 0.5 * swiglu(h, f1_gate[i], f1_up[i], f1_down[i]),
                       ln1_g[i], ln1_b[i])
        h = layer_norm(ALPHA * h + hybrid_mixer(h, w_in[i], b_fgate[i], pool_w[i], pool_scale[i],
                                                conv_w[i], conv_b[i], dt_bias[i], a_log[i],
                                                d_skip[i], ssd_norm_w[i], w_out[i]),
                       ln2_g[i], ln2_b[i])
        h = layer_norm(ALPHA * h + 0.5 * swiglu(h, f2_gate[i], f2_up[i], f2_down[i]),
                       ln3_g[i], ln3_b[i])
    return h[:, N_META:]
```

```cpp
#include <hip/hip_runtime.h>
#include <hip/hip_cooperative_groups.h>
#include <cstdio>
namespace cg = cooperative_groups;

#ifndef PER_PHASE_LAUNCH
#define PER_PHASE_LAUNCH 0
#endif

#define LAS __attribute__((address_space(3)))
#define DI __device__ __forceinline__
typedef unsigned short bf16_t;
typedef short bf16x8 __attribute__((ext_vector_type(8)));
typedef short s16x4 __attribute__((ext_vector_type(4)));
typedef float f32x4 __attribute__((ext_vector_type(4)));
typedef unsigned u32x4 __attribute__((ext_vector_type(4)));
typedef unsigned u32x2 __attribute__((ext_vector_type(2)));

constexpr int D = 2048, NBATCH = 4, SEQ = 4096, NMETA = 16, LT = SEQ + NMETA  , R = NBATCH * LT  ;
constexpr int FF = 5632, NIN = 4864  , NBLK = 33, NTHR = 512, DEPTH = 2;
constexpr int C_Q = 0, C_K = 512, C_V = 1024, C_U = 1536, C_Z = 2048, C_X = 3072, C_F = 4608;
constexpr float ALPHA = 1.41421356237309515f, LN_EPS = 1e-5f, RMS_EPS = 1e-5f, LOG2E = 1.4426950408889634f;
constexpr int LDS_BYTES = 159744;

constexpr size_t SZ_WGU = (size_t)2 * FF * D * 2, SZ_WDN = (size_t)D * FF * 2, SZ_WIN = (size_t)NIN * D * 2, SZ_WOUT = (size_t)D * D * 2, SZ_PWT = (size_t)4 * 128 * 128 * 2;
constexpr size_t WS_WGU = 0;
constexpr size_t WS_WDN = WS_WGU + 4 * SZ_WGU;
constexpr size_t WS_WIN = WS_WDN + 4 * SZ_WDN;
constexpr size_t WS_WOUT = WS_WIN + 2 * SZ_WIN;
constexpr size_t WS_PWT = WS_WOUT + 2 * SZ_WOUT;
constexpr size_t WS_H32 = WS_PWT + 2 * SZ_PWT;
constexpr size_t WS_H16 = WS_H32 + (size_t)R * D * 4;
constexpr size_t SZ_ST = (size_t)NBATCH * NBLK * 16 * 64 * 128 * 4;
constexpr size_t WS_BIG = WS_H16 + SZ_ST;
constexpr size_t SZ_PROJ = (size_t)R * NIN * 2, SZ_Y = (size_t)R * D * 2;
constexpr size_t WS_FDT = WS_BIG + SZ_PROJ + SZ_Y;
constexpr size_t WS_CC = WS_FDT + (size_t)R * 32 * 4;
constexpr size_t WS_CD = WS_CC + (size_t)NBATCH * 8 * LT * 4;
constexpr size_t WS_ZERO = WS_CD + (size_t)NBATCH * NBLK * 16 * 4 + 256;
constexpr size_t WS_Q = WS_ZERO;
constexpr size_t WS_STAT = WS_Q + 256;
constexpr size_t WS_GWGU = WS_STAT + (size_t)7 * R * 2 * 4;
constexpr size_t WS_BWGU = WS_GWGU + (size_t)4 * 2 * FF * 4;
constexpr size_t WS_GWIN = WS_BWGU + (size_t)4 * 2 * FF * 4;
constexpr size_t WS_BWIN = WS_GWIN + (size_t)2 * NIN * 4;
constexpr size_t WS_BAR = WS_BWIN + (size_t)2 * NIN * 4;
constexpr size_t WS_END = WS_BAR + 3456 * 4 + 256 - (3456 * 4) % 256;
constexpr size_t ZERO_BYTES = WS_END - WS_ZERO;
static_assert((size_t)R * FF * 2 <= SZ_PROJ + SZ_Y, "ACT fits");
static_assert(SZ_ST >= (size_t)R * D * 2, "H16 fits");

DI unsigned cvt_pk_bf16(float lo, float hi) { unsigned r; asm("v_cvt_pk_bf16_f32 %0, %1, %2" : "=v"(r) : "v"(lo), "v"(hi)); return r; }
DI float bf2f(bf16_t v) { return __uint_as_float(((unsigned)v) << 16); }
DI bf16_t f2bf(float f) { return (bf16_t)(cvt_pk_bf16(f, 0.f) & 0xffffu); }
DI float silu_f(float x) { return x * __builtin_amdgcn_rcpf(1.f + __expf(-x)); }
DI float softplus_f(float x) { return x > 20.f ? x : __logf(1.f + __expf(x)); }
DI float shx(float v, int mask, int lane) { return __uint_as_float((unsigned)__builtin_amdgcn_ds_bpermute((lane ^ mask) << 2, (int)__float_as_uint(v))); }
DI float wave_sum(float v, int lane) {
#pragma unroll
    for (int o = 1; o < 64; o <<= 1) v += shx(v, o, lane);
    return v;
}
DI float wave_incl_scan(float x, int lane) {
#pragma unroll
    for (int o = 1; o < 64; o <<= 1) { const float v = __uint_as_float((unsigned)__builtin_amdgcn_ds_bpermute((lane - o) << 2, (int)__float_as_uint(x))); if (lane >= o) x += v; }
    return x;
}
DI f32x4 mfma16(bf16x8 a, bf16x8 b, f32x4 c) { return __builtin_amdgcn_mfma_f32_16x16x32_bf16(a, b, c, 0, 0, 0); }
DI int memrow_meta(int r) { return (r >> 4) * LT + (r & 15); }
#define RLF(v, k) __uint_as_float(__builtin_amdgcn_readlane(__float_as_uint(v), (k)))
#define LDS_WAIT() asm volatile("s_waitcnt lgkmcnt(0)" ::: "memory")
typedef float f32x2 __attribute__((ext_vector_type(2)));
DI f32x2 row_stats(const float* st, size_t row) {
    float rstd = 1.f, mu = 0.f;
    if (st) { const f32x2 sq = *(const f32x2*)(st + row * 2); mu = sq.x * (1.f / D); const float var = fmaxf(sq.y * (1.f / D) - mu * mu, 0.f); rstd = __builtin_amdgcn_rsqf(var + LN_EPS); }
    return (f32x2){rstd, mu};
}

namespace pg8 {
constexpr int BM = 256, BK = 64, HALF = 128, HTB = HALF * BK * 2, NXCD = 8, WGM = 8;
DI int lds_byte(int r, int c) { const int st = (r >> 4) * 2 + (c >> 5), rr = r & 15, cc = c & 31, ob = rr * 64 + cc * 2; return st * 1024 + (ob ^ (((ob >> 9) & 1) << 5)); }
DI void stage_rc(int b, int& Rr, int& Cc) { const int st = b / 1024, sb = b % 1024, swz = sb ^ (((sb >> 9) & 1) << 5); Rr = (st >> 1) * 16 + swz / 64; Cc = (st & 1) * 32 + (swz % 64) / 2; }
DI int perm32(int rho) { const int n = rho >> 4, i = rho & 15; return 8 * (i >> 2) + 4 * n + (i & 3); }
struct Unit { int pm, pn; };
struct Gemm { const bf16_t* A; const bf16_t* Bt; int N, K; };
DI int rowbase(int pm) { return (pm >> 4) * LT + NMETA + (pm & 15) * 256; }
struct StaticOrder {
    int nM, nN, nwg, G, c;
    DI void init(int N, int G_, int c_) { nM = 64; nN = N / BM; nwg = nM * nN; G = G_; c = c_; }
    DI bool next(int i, Unit& u) const {
        const int L = __builtin_amdgcn_readfirstlane(i * G + c); if (L >= nwg) return false;
        int wgid = L; { const int q = nwg / NXCD, r = nwg % NXCD, xcd = wgid % NXCD, off = wgid / NXCD; wgid = (xcd < r ? xcd * (q + 1) : r * (q + 1) + (xcd - r) * q) + off; }
        const int nig = WGM * nN, gid = wgid / nig, fm = gid * WGM, gsz = (nM - fm) < WGM ? (nM - fm) : WGM;
        u.pm = fm + ((wgid % nig) % gsz); u.pn = (wgid % nig) / gsz; return true;
    }
};

constexpr int TAB_OFF = 131072, TABC_OFF = 131072 + 2048, TABC_BYTES = 2048, TAB_MAXU = 11;
struct EpiGU {
    static constexpr bool PERM = true, TAB = true; bf16_t* O; const float* ST; const float* GW; const float* BW;
    DI f32x2 row_fetch(int pm, int tid) const { const f32x2 rs = row_stats(ST, (size_t)(rowbase(pm) + (tid & 255))); return (f32x2){rs.x, rs.x * rs.y}; }
    DI float col_fetch(int pn, int tid) const { return tid < 256 ? GW[pn * 256 + tid] : BW[pn * 256 + tid - 256]; }
    DI void operator()(const f32x4 (&acc)[2][2][4][2], const Unit& u, int wr, int wc, int fr, int fq, const LAS unsigned char* tabR, const LAS unsigned char* tabC) const {
        asm volatile("" : "+v"(fr), "+v"(fq));
        const int row0 = rowbase(u.pm) + wr * 64 + fr, col0 = u.pn * 128 + wc * 32 + 8 * fq, lc0 = wc * 32 + 8 * fq;
        const LAS f32x2* tr = (const LAS f32x2*)tabR; const LAS float* tg = (const LAS float*)tabC; const LAS float* tb = (const LAS float*)(tabC + 1024);
        f32x4 gw[2][2], bw[2][2];
#pragma unroll
        for (int bj = 0; bj < 2; ++bj)
#pragma unroll
            for (int n = 0; n < 2; ++n) { gw[bj][n] = *(const LAS f32x4*)(tg + lc0 + bj * HALF + 4 * n); bw[bj][n] = *(const LAS f32x4*)(tb + lc0 + bj * HALF + 4 * n); }
#pragma unroll
        for (int ai = 0; ai < 2; ++ai)
#pragma unroll
            for (int m = 0; m < 4; ++m) {
                const size_t row = (size_t)(row0 + ai * HALF + m * 16);
                const f32x2 rs = tr[ai * HALF + wr * 64 + m * 16 + fr]; const float rstd = rs.x, rm = rs.y;
                bf16_t* rowp = O + row * FF + col0;
                const f32x4 g0 = acc[ai][0][m][0] * rstd - gw[0][0] * rm + bw[0][0], g1 = acc[ai][0][m][1] * rstd - gw[0][1] * rm + bw[0][1];
                const f32x4 u0 = acc[ai][1][m][0] * rstd - gw[1][0] * rm + bw[1][0], u1 = acc[ai][1][m][1] * rstd - gw[1][1] * rm + bw[1][1];
                f32x4 v0, v1;
#pragma unroll
                for (int j = 0; j < 4; ++j) { v0[j] = silu_f(g0[j]) * u0[j]; v1[j] = silu_f(g1[j]) * u1[j]; }
                u32x4 w; w.x = cvt_pk_bf16(v0[0], v0[1]); w.y = cvt_pk_bf16(v0[2], v0[3]); w.z = cvt_pk_bf16(v1[0], v1[1]); w.w = cvt_pk_bf16(v1[2], v1[3]);
                *(u32x4*)rowp = w;
            }
    }
};
template <bool HALFC> struct EpiRes {
    static constexpr bool PERM = false, TAB = false; static constexpr float coef = HALFC ? 0.5f : 1.0f; float* H; bf16_t* H16; const float* STin; const float* lg; const float* lb; float* STout;
    DI f32x2 row_fetch(int, int) const { return (f32x2){0.f, 0.f}; }
    DI float col_fetch(int, int) const { return 0.f; }
    DI void operator()(const f32x4 (&acc)[2][2][4][2], const Unit& u, int wr, int wc, int fr, int fq, const LAS unsigned char*, const LAS unsigned char*) const {
        asm volatile("" : "+v"(fr), "+v"(fq));
        const int row0 = rowbase(u.pm) + wr * 64 + fr, col0 = u.pn * BM + wc * 32 + 4 * fq;
        const bool has = STin != nullptr;
#pragma unroll
        for (int ai = 0; ai < 2; ++ai)
#pragma unroll
            for (int mp = 0; mp < 2; ++mp) {
                f32x4 hv[2][2][2]; f32x2 rsv2[2]; f32x4 gq[2][2], bq[2][2];
#pragma unroll
                for (int mm = 0; mm < 2; ++mm) { rsv2[mm] = row_stats(STin, (size_t)(row0 + ai * HALF + (2 * mp + mm) * 16));
                    const float* rowp = H + (size_t)(row0 + ai * HALF + (2 * mp + mm) * 16) * D + col0;
#pragma unroll
                    for (int bj = 0; bj < 2; ++bj)
#pragma unroll
                        for (int n = 0; n < 2; ++n) hv[mm][bj][n] = *(const f32x4*)(rowp + bj * HALF + n * 16); }
#pragma unroll
                for (int bj = 0; bj < 2; ++bj)
#pragma unroll
                    for (int n = 0; n < 2; ++n) {
                        gq[bj][n] = (f32x4){1.f, 1.f, 1.f, 1.f}; bq[bj][n] = (f32x4){0.f, 0.f, 0.f, 0.f};
                        if (has) { gq[bj][n] = *(const f32x4*)(lg + col0 + bj * HALF + n * 16); bq[bj][n] = *(const f32x4*)(lb + col0 + bj * HALF + n * 16); } }
#pragma unroll
                for (int mm = 0; mm < 2; ++mm) {
                    const int m = 2 * mp + mm;
                    const size_t row = (size_t)(row0 + ai * HALF + m * 16);
                    const float rstd = rsv2[mm].x, mu = rsv2[mm].y;
                    float* rowp = H + row * D + col0; bf16_t* row16 = H16 + row * D + col0;
                    float ps = 0.f, pq = 0.f;
#pragma unroll
                    for (int bj = 0; bj < 2; ++bj)
#pragma unroll
                        for (int n = 0; n < 2; ++n) {
                            const f32x4 h = (hv[mm][bj][n] - mu) * rstd * gq[bj][n] + bq[bj][n];
                            const f32x4 xn = h * ALPHA + acc[ai][bj][m][n] * coef;
                            *(f32x4*)(rowp + bj * HALF + n * 16) = xn;
                            u32x2 w; w.x = cvt_pk_bf16(xn[0], xn[1]); w.y = cvt_pk_bf16(xn[2], xn[3]); *(u32x2*)(row16 + bj * HALF + n * 16) = w;
                            ps += (xn[0] + xn[1]) + (xn[2] + xn[3]); pq += (xn[0] * xn[0] + xn[1] * xn[1]) + (xn[2] * xn[2] + xn[3] * xn[3]);
                        }
                    ps += shx(ps, 16, (fr + 16 * fq)); ps += shx(ps, 32, (fr + 16 * fq)); pq += shx(pq, 16, (fr + 16 * fq)); pq += shx(pq, 32, (fr + 16 * fq));
                    if (fq == 0) { unsafeAtomicAdd(STout + row * 2, ps); unsafeAtomicAdd(STout + row * 2 + 1, pq); }
                }
            }
    }
};
struct EpiWin {
    static constexpr bool PERM = true, TAB = true; bf16_t* P; float* FDT; const float* ST; const float* GW; const float* BW;
    DI f32x2 row_fetch(int pm, int tid) const { const f32x2 rs = row_stats(ST, (size_t)(rowbase(pm) + (tid & 255))); return (f32x2){rs.x, rs.x * rs.y}; }
    DI float col_fetch(int pn, int tid) const { return tid < 256 ? GW[pn * 256 + tid] : BW[pn * 256 + tid - 256]; }
    DI void operator()(const f32x4 (&acc)[2][2][4][2], const Unit& u, int wr, int wc, int fr, int fq, const LAS unsigned char* tabR, const LAS unsigned char* tabC) const {
        asm volatile("" : "+v"(fr), "+v"(fq));
        const int row0 = rowbase(u.pm) + wr * 64 + fr, col0 = u.pn * BM + wc * 32 + 8 * fq, lc0 = wc * 32 + 8 * fq;
        const LAS f32x2* tr = (const LAS f32x2*)tabR; const LAS float* tg = (const LAS float*)tabC; const LAS float* tb = (const LAS float*)(tabC + 1024);
        f32x4 gw[2][2], bw[2][2];
#pragma unroll
        for (int bj = 0; bj < 2; ++bj)
#pragma unroll
            for (int n = 0; n < 2; ++n) { gw[bj][n] = *(const LAS f32x4*)(tg + lc0 + bj * HALF + 4 * n); bw[bj][n] = *(const LAS f32x4*)(tb + lc0 + bj * HALF + 4 * n); }
#pragma unroll
        for (int ai = 0; ai < 2; ++ai)
#pragma unroll
            for (int m = 0; m < 4; ++m) {
                const size_t row = (size_t)(row0 + ai * HALF + m * 16);
                const f32x2 rs = tr[ai * HALF + wr * 64 + m * 16 + fr]; const float rstd = rs.x, rm = rs.y;
                bf16_t* rowp = P + row * NIN + col0;
                f32x4 v[2][2];
#pragma unroll
                for (int bj = 0; bj < 2; ++bj) {
                    v[bj][0] = acc[ai][bj][m][0] * rstd - gw[bj][0] * rm + bw[bj][0]; v[bj][1] = acc[ai][bj][m][1] * rstd - gw[bj][1] * rm + bw[bj][1];
                    u32x4 w; w.x = cvt_pk_bf16(v[bj][0][0], v[bj][0][1]); w.y = cvt_pk_bf16(v[bj][0][2], v[bj][0][3]); w.z = cvt_pk_bf16(v[bj][1][0], v[bj][1][1]); w.w = cvt_pk_bf16(v[bj][1][2], v[bj][1][3]);
                    *(u32x4*)(rowp + bj * HALF) = w;
                }
                if (u.pn == 18 && wc == 0 && fq < 3) { float* f = FDT + row * 32 + 8 * fq; *(f32x4*)f = v[0][0]; *(f32x4*)(f + 4) = v[0][1]; }
            }
    }
};

#ifndef PG8_SP2
#define PG8_SP2 true
#endif
#ifndef PG8_ALIGN
#define PG8_ALIGN true
#endif
template <class Epi, bool SP2 = PG8_SP2, bool ALIGN_EPI = PG8_ALIGN>
DI void gemm_phase(LAS unsigned char* lds, const Gemm g, const StaticOrder& S, const Epi& E) {
    int tid_ = threadIdx.x; asm volatile("" : "+v"(tid_));
    const int tid = tid_, wid = __builtin_amdgcn_readfirstlane(tid >> 6), lane = tid & 63, wr = wid >> 2, wc = wid & 3, fr = lane & 15, fq = lane >> 4;
    const int K = g.K, nt = K / BK;
    unsigned voffA[2], voffB[2];
#pragma unroll
    for (int i = 0; i < 2; ++i) { int Rr, Cc; stage_rc(tid * 16 + i * 8192, Rr, Cc); const int Rb = Epi::PERM ? ((Rr & ~31) + perm32(Rr & 31)) : Rr;
        voffA[i] = (unsigned)(Rr * K + Cc) * 2u; voffB[i] = (unsigned)(Rb * K + Cc) * 2u; }
    const size_t kstep = (size_t)(BK * 2);
    const size_t hstep = (size_t)HALF * K * 2;
    const size_t tstep = 2 * hstep;
    const size_t rstep = (size_t)K * 2;
    const unsigned ldsw = (unsigned)wid * 1024u;
    const int aoff = lds_byte(wr * 64 + fr, fq * 8), boff = lds_byte(wc * 32 + fr, fq * 8);
#define PG8_SA(b, h) (((b) * 2 + (h)) * HTB)
#define PG8_SB(b, h) ((4 + (b) * 2 + (h)) * HTB)
#define PG8_STAGE(bufoff, gbase, voff) do { _Pragma("unroll") for (int _i = 0; _i < 2; ++_i) \
        __builtin_amdgcn_global_load_lds((const unsigned*)((const char*)(gbase) + (voff)[_i]), (LAS unsigned*)(lds + (bufoff) + ldsw + _i * 8192), 16, 0, 0); } while (0)
#define PG8_LDA(dst, b, h) do { _Pragma("unroll") for (int m = 0; m < 4; ++m) _Pragma("unroll") for (int k = 0; k < 2; ++k) dst[m][k] = *(const LAS bf16x8*)(lds + PG8_SA(b, h) + aoff + m * 2048 + k * 1024); } while (0)
#define PG8_LDB(dst, b, h) do { _Pragma("unroll") for (int n = 0; n < 2; ++n) _Pragma("unroll") for (int k = 0; k < 2; ++k) dst[n][k] = *(const LAS bf16x8*)(lds + PG8_SB(b, h) + boff + n * 2048 + k * 1024); } while (0)
#define PG8_MMA(ai, bj, At, Bt) do { __builtin_amdgcn_s_setprio(1); _Pragma("unroll") for (int m = 0; m < 4; ++m) _Pragma("unroll") for (int n = 0; n < 2; ++n) _Pragma("unroll") for (int k = 0; k < 2; ++k) \
        acc[ai][bj][m][n] = __builtin_amdgcn_mfma_f32_16x16x32_bf16(Bt[n][k], At[m][k], acc[ai][bj][m][n], 0, 0, 0); __builtin_amdgcn_s_setprio(0); } while (0)
#define PG8_WAIT_V(n) asm volatile("s_waitcnt vmcnt(" #n ")" ::: "memory")
#define PG8_WAIT_L(n) asm volatile("s_waitcnt lgkmcnt(" #n ")" ::: "memory")
#define PG8_BAR __builtin_amdgcn_s_barrier()
#define PG8_SCHED __builtin_amdgcn_sched_barrier(0)
    Unit cur, nxt; int ui = 0;
    if (!S.next(0, cur)) return;
    f32x4 acc[2][2][4][2];
#pragma unroll
    for (int a = 0; a < 2; ++a)
#pragma unroll
        for (int b = 0; b < 2; ++b)
#pragma unroll
            for (int m = 0; m < 4; ++m)
#pragma unroll
                for (int n = 0; n < 2; ++n) acc[a][b][m][n] = (f32x4){0.f, 0.f, 0.f, 0.f};
    bf16x8 At[4][2], B0[2][2], B1[2][2];
    const char* cA = (const char*)g.A + (size_t)rowbase(cur.pm) * rstep; const char* cB = (const char*)g.Bt + (size_t)cur.pn * tstep;
    if (Epi::TAB) {
        const f32x2 rv = E.row_fetch(cur.pm, tid);
        float cv[TAB_MAXU];
#pragma unroll
        for (int i = 0; i < TAB_MAXU; ++i) { Unit uu; cv[i] = S.next(i, uu) ? E.col_fetch(uu.pn, tid) : 0.f; }
        if (tid < 256) *(LAS f32x2*)(lds + TAB_OFF + tid * 8) = rv;
#pragma unroll
        for (int i = 0; i < TAB_MAXU; ++i) *(LAS float*)(lds + TABC_OFF + i * TABC_BYTES + tid * 4) = cv[i];
        asm volatile("s_waitcnt vmcnt(0) lgkmcnt(0)" ::: "memory");
    }
    if constexpr (SP2) {
        PG8_STAGE(PG8_SB(0, 0), cB, voffB); PG8_STAGE(PG8_SB(0, 1), cB + hstep, voffB); PG8_STAGE(PG8_SA(0, 0), cA, voffA); PG8_STAGE(PG8_SA(0, 1), cA + hstep, voffA);
        if (wr == 1) PG8_BAR;
        PG8_WAIT_V(2); PG8_BAR;
        PG8_STAGE(PG8_SB(1, 0), cB + kstep, voffB); PG8_STAGE(PG8_SA(1, 0), cA + kstep, voffA); PG8_STAGE(PG8_SB(1, 1), cB + hstep + kstep, voffB);
        PG8_WAIT_V(6); PG8_BAR;
    } else {
    PG8_STAGE(PG8_SB(0, 0), cB, voffB); PG8_STAGE(PG8_SA(0, 0), cA, voffA); PG8_STAGE(PG8_SB(0, 1), cB + hstep, voffB); PG8_STAGE(PG8_SA(0, 1), cA + hstep, voffA);
    if (wr == 1) PG8_BAR;
    PG8_WAIT_V(4); PG8_BAR;
    PG8_STAGE(PG8_SB(1, 0), cB + kstep, voffB); PG8_STAGE(PG8_SA(1, 0), cA + kstep, voffA); PG8_STAGE(PG8_SB(1, 1), cB + hstep + kstep, voffB);
    PG8_WAIT_V(6); PG8_BAR;
    }
    for (;;) {
        const bool has_next = S.next(ui + 1, nxt);
        const char* nA = has_next ? (const char*)g.A + (size_t)rowbase(nxt.pm) * rstep : cA; const char* nB = has_next ? (const char*)g.Bt + (size_t)nxt.pn * tstep : cB;
        for (int t = 0; t < nt; t += 2) {
            const bool last = (t == nt - 2);
            const char* a1 = cA + (size_t)(t + 1) * kstep;
            const char* a2 = last ? nA : cA + (size_t)(t + 2) * kstep; const char* b2 = last ? nB : cB + (size_t)(t + 2) * kstep;
            const char* a3 = a2 + kstep; const char* b3 = b2 + kstep;
            if constexpr (SP2) {
            PG8_LDB(B0, 0, 0); PG8_LDB(B1, 0, 1); PG8_SCHED; PG8_LDA(At, 0, 0); PG8_STAGE(PG8_SA(1, 1), a1 + hstep, voffA);
            PG8_WAIT_V(8); PG8_WAIT_L(0); PG8_BAR; PG8_MMA(0, 0, At, B0); PG8_MMA(0, 1, At, B1); PG8_BAR; PG8_SCHED;
            PG8_LDA(At, 0, 1); PG8_STAGE(PG8_SB(0, 0), b2, voffB); PG8_STAGE(PG8_SB(0, 1), b2 + hstep, voffB); PG8_STAGE(PG8_SA(0, 0), a2, voffA);
            PG8_WAIT_V(8); PG8_WAIT_L(0); PG8_BAR; PG8_MMA(1, 0, At, B0); PG8_MMA(1, 1, At, B1); PG8_BAR; PG8_SCHED;
            PG8_LDB(B0, 1, 0); PG8_LDB(B1, 1, 1); PG8_SCHED; PG8_LDA(At, 1, 0); PG8_STAGE(PG8_SA(0, 1), a2 + hstep, voffA);
            PG8_WAIT_V(8); PG8_WAIT_L(0); PG8_BAR; PG8_MMA(0, 0, At, B0); PG8_MMA(0, 1, At, B1); PG8_BAR; PG8_SCHED;
            PG8_LDA(At, 1, 1); PG8_STAGE(PG8_SB(1, 0), b3, voffB); PG8_STAGE(PG8_SB(1, 1), b3 + hstep, voffB); PG8_STAGE(PG8_SA(1, 0), a3, voffA);
            PG8_WAIT_V(8); PG8_WAIT_L(0); PG8_BAR; PG8_MMA(1, 0, At, B0); PG8_MMA(1, 1, At, B1); PG8_BAR; PG8_SCHED;
            } else {
            PG8_LDB(B0, 0, 0); PG8_SCHED; PG8_LDA(At, 0, 0); PG8_STAGE(PG8_SA(1, 1), a1 + hstep, voffA);
            PG8_WAIT_L(8); PG8_BAR; PG8_WAIT_L(0); PG8_MMA(0, 0, At, B0); PG8_BAR; PG8_SCHED;
            PG8_LDB(B1, 0, 1); PG8_STAGE(PG8_SB(0, 0), b2, voffB);
            PG8_BAR; PG8_WAIT_L(0); PG8_MMA(0, 1, At, B1); PG8_BAR;
            PG8_LDA(At, 0, 1); PG8_STAGE(PG8_SA(0, 0), a2, voffA);
            PG8_BAR; PG8_WAIT_L(0); PG8_MMA(1, 0, At, B0); PG8_BAR; PG8_SCHED;
            PG8_STAGE(PG8_SB(0, 1), b2 + hstep, voffB);
            PG8_WAIT_V(6); PG8_BAR; PG8_MMA(1, 1, At, B1); PG8_BAR;
            PG8_LDB(B0, 1, 0); PG8_SCHED; PG8_LDA(At, 1, 0); PG8_STAGE(PG8_SA(0, 1), a2 + hstep, voffA);
            PG8_WAIT_L(8); PG8_BAR; PG8_WAIT_L(0); PG8_MMA(0, 0, At, B0); PG8_BAR; PG8_SCHED;
            PG8_LDB(B1, 1, 1); PG8_STAGE(PG8_SB(1, 0), b3, voffB);
            PG8_BAR; PG8_WAIT_L(0); PG8_MMA(0, 1, At, B1); PG8_BAR;
            PG8_LDA(At, 1, 1); PG8_STAGE(PG8_SA(1, 0), a3, voffA);
            PG8_BAR; PG8_WAIT_L(0); PG8_MMA(1, 0, At, B0); PG8_BAR; PG8_SCHED;
            PG8_STAGE(PG8_SB(1, 1), b3 + hstep, voffB);
            PG8_WAIT_V(6); PG8_BAR; PG8_MMA(1, 1, At, B1); PG8_BAR;
            }
        }
        if constexpr (ALIGN_EPI) { if (wr == 0) PG8_BAR; }
        E(acc, cur, wr, wc, fr, fq, lds + TAB_OFF, lds + TABC_OFF + (ui < TAB_MAXU ? ui : TAB_MAXU - 1) * TABC_BYTES);
        if (!has_next) break;
#pragma unroll
        for (int a = 0; a < 2; ++a)
#pragma unroll
            for (int b = 0; b < 2; ++b)
#pragma unroll
                for (int m = 0; m < 4; ++m)
#pragma unroll
                    for (int n = 0; n < 2; ++n) acc[a][b][m][n] = (f32x4){0.f, 0.f, 0.f, 0.f};
        cur = nxt; cA = nA; cB = nB; ++ui;
        if constexpr (ALIGN_EPI) { if (wr == 1) PG8_BAR; }
    }
    PG8_WAIT_V(0);
    if constexpr (!ALIGN_EPI) { if (wr == 0) PG8_BAR; }
    PG8_BAR;
#undef PG8_SA
#undef PG8_SB
#undef PG8_STAGE
#undef PG8_LDA
#undef PG8_LDB
#undef PG8_MMA
#undef PG8_WAIT_V
#undef PG8_WAIT_L
#undef PG8_BAR
#undef PG8_SCHED
}
}

template <int KIND>
DI void skinny_phase(LAS unsigned char* lds, const bf16_t* A, int K, const bf16_t* Wt, int nunits, bf16_t* O16, float* O32, float coef,
                     const float* STin, const float* GW, const float* BW, const float* lg, const float* lb, float* STout, bf16_t* H16o) {
    int tid_ = threadIdx.x; asm volatile("" : "+v"(tid_));
    const int tid = tid_, wid = __builtin_amdgcn_readfirstlane(tid >> 6), lane = tid & 63, fr = lane & 15, fq = lane >> 4;
    LAS float* red = (LAS float*)lds;
    LAS float* red2 = (LAS float*)(lds + 16384);
    const int kper = (K / 32) / 8, ks0 = wid * kper, ks1 = ks0 + kper;
    const bf16x8 zero8 = (bf16x8){0, 0, 0, 0, 0, 0, 0, 0};
    for (int u = blockIdx.x; u < nunits; u += gridDim.x) {
        int r0, r1;
        if (KIND == 0) { const int j0 = 16 * u; r0 = (j0 >> 7) * 256 + (j0 & 127); r1 = r0 + 128; } else { r0 = 32 * u; r1 = r0 + 16; }
        f32x4 acc0 = (f32x4){0.f, 0.f, 0.f, 0.f}, acc1 = (f32x4){0.f, 0.f, 0.f, 0.f};
        const bf16_t* a0 = A + (size_t)fr * K + fq * 8;
        const bf16_t* b0 = Wt + (size_t)(r0 + fr) * K + fq * 8;
        const bf16_t* b1 = Wt + (size_t)(r1 + fr) * K + fq * 8;
        bf16x8 ca[4], cb0[4], cb1[4];
#pragma unroll
        for (int s = 0; s < 4; ++s) { const bool ok = ks0 + s < ks1; const int k = (ks0 + s) * 32; ca[s] = zero8; cb0[s] = zero8; cb1[s] = zero8;
            if (ok) { ca[s] = *(const bf16x8*)(a0 + k); cb0[s] = *(const bf16x8*)(b0 + k); cb1[s] = *(const bf16x8*)(b1 + k); } }
        for (int ks = ks0; ks < ks1; ks += 4) {
            bf16x8 na[4], nb0[4], nb1[4];
#pragma unroll
            for (int s = 0; s < 4; ++s) { const bool ok = ks + 4 + s < ks1; const int k = (ks + 4 + s) * 32; na[s] = zero8; nb0[s] = zero8; nb1[s] = zero8;
                if (ok) { na[s] = *(const bf16x8*)(a0 + k); nb0[s] = *(const bf16x8*)(b0 + k); nb1[s] = *(const bf16x8*)(b1 + k); } }
#pragma unroll
            for (int s = 0; s < 4; ++s) { acc0 = mfma16(ca[s], cb0[s], acc0); acc1 = mfma16(ca[s], cb1[s], acc1); }
#pragma unroll
            for (int s = 0; s < 4; ++s) { ca[s] = na[s]; cb0[s] = nb0[s]; cb1[s] = nb1[s]; }
        }
#pragma unroll
        for (int j = 0; j < 4; ++j) { red[(wid * 16 + 4 * fq + j) * 32 + fr] = acc0[j]; red[(wid * 16 + 4 * fq + j) * 32 + 16 + fr] = acc1[j]; }
        __syncthreads();
        { float s = 0.f;
#pragma unroll
          for (int w = 0; w < 8; ++w) s += red[w * 512 + tid];
          red2[tid] = s; }
        __syncthreads();
        const int r = tid >> 5, c = tid & 31;
        const f32x2 rs_ = row_stats(STin, (size_t)r); const float rstd = rs_.x, mu = rs_.y;
        if (KIND == 0) {
            if (c < 16) { const float rm = rstd * mu;
                const float gv = red2[r * 32 + c] * rstd - rm * GW[r0 + c] + BW[r0 + c], uv = red2[r * 32 + 16 + c] * rstd - rm * GW[r1 + c] + BW[r1 + c];
                const bf16_t o = f2bf(silu_f(gv) * uv);
#pragma unroll
                for (int bb = 0; bb < NBATCH; ++bb) O16[((size_t)bb * LT + r) * FF + 16 * u + c] = o; }
        } else if (KIND == 1) {
            const int col = 32 * u + c;
            float h = O32[(size_t)r * D + col]; if (STin) h = (h - mu) * rstd * lg[col] + lb[col];
            const float xn = h * ALPHA + red2[tid] * coef; const bf16_t xb = f2bf(xn);
            float ps = xn, pq = xn * xn;
#pragma unroll
            for (int o = 1; o < 32; o <<= 1) { ps += shx(ps, o, lane); pq += shx(pq, o, lane); }
#pragma unroll
            for (int bb = 0; bb < NBATCH; ++bb) { const size_t row = (size_t)bb * LT + r; O32[row * D + col] = xn; H16o[row * D + col] = xb;
                if (c == 0) { unsafeAtomicAdd(STout + row * 2, ps); unsafeAtomicAdd(STout + row * 2 + 1, pq); } }
        } else {
            const int col = 32 * u + c; const float v = red2[tid] * rstd - rstd * mu * GW[col] + BW[col]; const bf16_t vb = f2bf(v);
#pragma unroll
            for (int bb = 0; bb < NBATCH; ++bb) { const size_t row = (size_t)bb * LT + r; O16[row * NIN + col] = vb;
                if (col >= C_F && col < C_F + 24) O32[row * 32 + col - C_F] = v; }
        }
        __syncthreads();
    }
}

DI void transpose_item(const float* W, int N, int k0, int sc, bf16_t* dst, int K, LAS float* scr, int lane, const float* gvec = nullptr, const float* bvec = nullptr, float* GWp = nullptr, float* BWp = nullptr) {
    float tv[32];
#pragma unroll
    for (int i = 0; i < 32; ++i) { const int kk = 2 * i + (lane >> 5); tv[i] = sc >= 0 ? W[(size_t)(k0 + kk) * N + sc] : 0.f; }
    if (gvec) {
        const float gl = gvec[k0 + lane], bl = bvec[k0 + lane]; float sg = 0.f, sb = 0.f; const bool hi = lane >= 32;
#pragma unroll
        for (int i = 0; i < 32; ++i) {
            const float g0 = RLF(gl, 2 * i), g1 = RLF(gl, 2 * i + 1), b0 = RLF(bl, 2 * i), b1 = RLF(bl, 2 * i + 1);
            sb += tv[i] * (hi ? b1 : b0); tv[i] *= (hi ? g1 : g0); sg += tv[i]; }
        sg += shx(sg, 32, lane); sb += shx(sb, 32, lane);
        if (lane < 32 && sc >= 0) { unsafeAtomicAdd(GWp + lane, sg); unsafeAtomicAdd(BWp + lane, sb); }
    }
#pragma unroll
    for (int i = 0; i < 32; ++i) { const int kk = 2 * i + (lane >> 5); scr[kk * 33 + (lane & 31)] = tv[i]; }
    LDS_WAIT();
    const int c = lane & 7;
#pragma unroll
    for (int j = 0; j < 4; ++j) { const int n = (lane >> 3) + 8 * j; const LAS float* s = scr + (8 * c) * 33 + n;
        u32x4 o; o.x = cvt_pk_bf16(s[0 * 33], s[1 * 33]); o.y = cvt_pk_bf16(s[2 * 33], s[3 * 33]); o.z = cvt_pk_bf16(s[4 * 33], s[5 * 33]); o.w = cvt_pk_bf16(s[6 * 33], s[7 * 33]);
        *(u32x4*)(dst + (size_t)n * K + 8 * c) = o; }
    LDS_WAIT();
}

struct Params { const float* in[25]; float* out; unsigned char* ws; int ph_lo, ph_hi; };

DI void prep_phase(LAS unsigned char* lds, const Params& p) {
    int tid_ = threadIdx.x; asm volatile("" : "+v"(tid_));
    const int tid = tid_, wid = __builtin_amdgcn_readfirstlane(tid >> 6), lane = tid & 63;
    LAS float* scr = (LAS float*)(lds + wid * 8448);
    const int gw = blockIdx.x * 8 + wid, NGW = gridDim.x * 8;
    constexpr int I_GU = 32 * 176, I_DN = 88 * 64, I_IN = 32 * 145, I_OUT = 32 * 64, I_PW = 8;
    constexpr int S0 = 8 * I_GU, S1 = S0 + 4 * I_DN, S2 = S1 + 2 * I_IN, S3 = S2 + 2 * I_OUT, S4 = S3 + 8 * I_PW;
    unsigned char* ws = p.ws;
    for (int it = gw; it < S4; it += NGW) {
        if (it < S0) {
            const int mi = it / I_GU, r = it % I_GU, q = mi >> 1, part = mi & 1, l = q >> 1, f = q & 1;
            const float* W = p.in[(f ? 20 : 2) + part] + (size_t)l * D * FF;
            const int kb = r / 176, nb = r % 176, n0 = 32 * nb;
            bf16_t* WT = (bf16_t*)(ws + WS_WGU + (size_t)q * SZ_WGU);
            const int drow = (n0 >> 7) * 256 + (n0 & 127) + part * 128;
            const float* gvec = f ? p.in[18] + l * D : (l ? p.in[23] + (l - 1) * D : nullptr);
            const float* bvec = f ? p.in[19] + l * D : (l ? p.in[24] + (l - 1) * D : nullptr);
            transpose_item(W, FF, 64 * kb, n0 + (lane & 31), WT + (size_t)drow * D + 64 * kb, D, scr, lane, gvec, bvec,
                           (float*)(ws + WS_GWGU) + (size_t)q * 2 * FF + drow, (float*)(ws + WS_BWGU) + (size_t)q * 2 * FF + drow);
        } else if (it < S1) {
            const int j = it - S0, q = j / I_DN, r = j % I_DN, l = q >> 1, f = q & 1;
            const float* W = p.in[f ? 22 : 4] + (size_t)l * FF * D;
            const int kb = r / 64, nb = r % 64;
            bf16_t* WT = (bf16_t*)(ws + WS_WDN + (size_t)q * SZ_WDN);
            transpose_item(W, D, 64 * kb, 32 * nb + (lane & 31), WT + (size_t)(32 * nb) * FF + 64 * kb, FF, scr, lane);
        } else if (it < S2) {
            const int j = it - S1, l = j / I_IN, r = j % I_IN;
            const float* W = p.in[7] + (size_t)l * D * 4632;
            const int kb = r / 145, nb = r % 145, dn = 32 * nb + (lane & 31);
            int sc;
            if (dn < 1536) sc = dn; else if (dn < 4608) sc = dn + 8; else if (dn < 4616) sc = 1536 + (dn - 4608); else if (dn < 4632) sc = dn; else sc = -1;
            bf16_t* WT = (bf16_t*)(ws + WS_WIN + (size_t)l * SZ_WIN);
            transpose_item(W, 4632, 64 * kb, sc, WT + (size_t)(32 * nb) * D + 64 * kb, D, scr, lane, p.in[5] + l * D, p.in[6] + l * D,
                           (float*)(ws + WS_GWIN) + (size_t)l * NIN + 32 * nb, (float*)(ws + WS_BWIN) + (size_t)l * NIN + 32 * nb);
        } else if (it < S3) {
            const int j = it - S2, l = j / I_OUT, r = j % I_OUT;
            const float* W = p.in[17] + (size_t)l * D * D;
            const int kb = r / 64, nb = r % 64;
            bf16_t* WT = (bf16_t*)(ws + WS_WOUT + (size_t)l * SZ_WOUT);
            transpose_item(W, D, 64 * kb, 32 * nb + (lane & 31), WT + (size_t)(32 * nb) * D + 64 * kb, D, scr, lane);
        } else {
            const int j = it - S3, lg = j / I_PW, r = j % I_PW;
            const float* W = p.in[9] + (size_t)lg * 128 * 128;
            const int kb = r / 4, nb = r % 4;
            bf16_t* WT = (bf16_t*)(ws + WS_PWT) + (size_t)lg * 128 * 128;
            transpose_item(W, 128, 64 * kb, 32 * nb + (lane & 31), WT + (size_t)(32 * nb) * 128 + 64 * kb, 128, scr, lane);
        }
    }
    float* H32 = (float*)(ws + WS_H32); bf16_t* H16 = (bf16_t*)(ws + WS_H16);
    for (int row = gw; row < R; row += NGW) {
        const int b = row / LT, t = row % LT;
        const float* src = t < NMETA ? p.in[1] + (size_t)t * D : p.in[0] + ((size_t)b * SEQ + (t - NMETA)) * D;
#pragma unroll
        for (int j = 0; j < 8; ++j) { const int col = 4 * lane + 256 * j; const f32x4 v = *(const f32x4*)(src + col);
            *(f32x4*)(H32 + (size_t)row * D + col) = v; u32x2 w; w.x = cvt_pk_bf16(v[0], v[1]); w.y = cvt_pk_bf16(v[2], v[3]); *(u32x2*)(H16 + (size_t)row * D + col) = w; }
    }
}

DI void ln_phase(float* H32, bf16_t* H16, const float* g, const float* bta, float* out) {
    int tid_ = threadIdx.x; asm volatile("" : "+v"(tid_));
    const int tid = tid_, wid = __builtin_amdgcn_readfirstlane(tid >> 6), lane = tid & 63;
    const int gw = blockIdx.x * 8 + wid, NGW = gridDim.x * 8;
    f32x4 gv[8], bv[8];
#pragma unroll
    for (int j = 0; j < 8; ++j) { gv[j] = *(const f32x4*)(g + 4 * lane + 256 * j); bv[j] = *(const f32x4*)(bta + 4 * lane + 256 * j); }
    for (int row = gw; row < R; row += NGW) {
        float* hr = H32 + (size_t)row * D;
        f32x4 v[8]; float s = 0.f;
#pragma unroll
        for (int j = 0; j < 8; ++j) { v[j] = *(const f32x4*)(hr + 4 * lane + 256 * j); s += (v[j][0] + v[j][1]) + (v[j][2] + v[j][3]); }
        const float mean = wave_sum(s, lane) * (1.f / D); float s2 = 0.f;
#pragma unroll
        for (int j = 0; j < 8; ++j) { v[j] = v[j] - mean; s2 += (v[j][0] * v[j][0] + v[j][1] * v[j][1]) + (v[j][2] * v[j][2] + v[j][3] * v[j][3]); }
        const float rstd = __builtin_amdgcn_rsqf(wave_sum(s2, lane) * (1.f / D) + LN_EPS);
        if (out) {
            const int b = row / LT, t = row % LT;
            if (t >= NMETA) { float* orow = out + ((size_t)b * SEQ + (t - NMETA)) * D;
#pragma unroll
                for (int j = 0; j < 8; ++j) *(f32x4*)(orow + 4 * lane + 256 * j) = v[j] * rstd * gv[j] + bv[j]; }
        } else {
            bf16_t* br = H16 + (size_t)row * D;
#pragma unroll
            for (int j = 0; j < 8; ++j) { const f32x4 y = v[j] * rstd * gv[j] + bv[j]; *(f32x4*)(hr + 4 * lane + 256 * j) = y;
                u32x2 w; w.x = cvt_pk_bf16(y[0], y[1]); w.y = cvt_pk_bf16(y[2], y[3]); *(u32x2*)(br + 4 * lane + 256 * j) = w; }
        }
    }
}

DI void conv16(const bf16_t* P, int b, int t, int ch0, const float* cw, const float* cb, float (&o)[16]) {
    if (t < 0) {
#pragma unroll
        for (int e = 0; e < 16; ++e) o[e] = 0.f;
        return;
    }
#pragma unroll
    for (int q = 0; q < 4; ++q) { const f32x4 bq = *(const f32x4*)(cb + ch0 + 4 * q); o[4 * q] = bq[0]; o[4 * q + 1] = bq[1]; o[4 * q + 2] = bq[2]; o[4 * q + 3] = bq[3]; }
#pragma unroll
    for (int j = 0; j < 4; ++j) {
        const int tt = t - 3 + j;
        if (tt >= 0) {
            const bf16_t* xp = P + ((size_t)b * LT + tt) * NIN + C_X + ch0;
            const u32x4 x0 = *(const u32x4*)xp, x1 = *(const u32x4*)(xp + 8);
            float wp[16];
#pragma unroll
            for (int q = 0; q < 4; ++q) { const f32x4 wq = *(const f32x4*)(cw + j * 1536 + ch0 + 4 * q); wp[4 * q] = wq[0]; wp[4 * q + 1] = wq[1]; wp[4 * q + 2] = wq[2]; wp[4 * q + 3] = wq[3]; }
#pragma unroll
            for (int q = 0; q < 4; ++q) {
                o[2 * q] += wp[2 * q] * __uint_as_float(x0[q] << 16); o[2 * q + 1] += wp[2 * q + 1] * __uint_as_float(x0[q] & 0xffff0000u);
                o[8 + 2 * q] += wp[8 + 2 * q] * __uint_as_float(x1[q] << 16); o[8 + 2 * q + 1] += wp[8 + 2 * q + 1] * __uint_as_float(x1[q] & 0xffff0000u);
            }
        }
    }
#pragma unroll
    for (int e = 0; e < 16; ++e) o[e] = silu_f(o[e]);
}

DI void cumsum_item(LAS unsigned char* lds, const float* FDT, const float* bfg, float* CC, int bh) {
    int tid_ = threadIdx.x; asm volatile("" : "+v"(tid_));
    const int tid = tid_, wid = __builtin_amdgcn_readfirstlane(tid >> 6), lane = tid & 63;
    LAS float* wsum = (LAS float*)lds;
    const int b = bh >> 3, h = bh & 7; const float bias = bfg[h];
    float xv[9];
#pragma unroll
    for (int j = 0; j < 9; ++j) { const int t = tid * 9 + j; xv[j] = t < LT ? FDT[((size_t)b * LT + t) * 32 + h] + bias : 0.f; }
    float s = 0.f;
#pragma unroll
    for (int j = 0; j < 9; ++j) { const int t = tid * 9 + j; const float x = xv[j]; s += t < LT ? fminf(x, 0.f) - __logf(1.f + __expf(-fabsf(x))) : 0.f; xv[j] = s; }
    const float incl = wave_incl_scan(s, lane);
    __syncthreads();
    if (lane == 63) wsum[wid] = incl;
    __syncthreads();
    float off = incl - s;
    for (int w = 0; w < wid; ++w) off += wsum[w];
#pragma unroll
    for (int j = 0; j < 9; ++j) { const int t = tid * 9 + j; if (t < LT) CC[(size_t)bh * LT + t] = off + xv[j]; }
}

DI void chunk_dt(const float* FDT, const float* dt_bias, const float* a_log, int b, int t0, int h, int lane, float& dt0, float& dt1, float& ac0, float& ac1, float& total) {
    const int ta = t0 + 2 * lane, tb = ta + 1;
    const float bias = dt_bias[h], a = -__expf(a_log[h]);
    dt0 = ta >= 0 ? softplus_f(FDT[((size_t)b * LT + ta) * 32 + 8 + h] + bias) : 0.f;
    dt1 = tb >= 0 ? softplus_f(FDT[((size_t)b * LT + tb) * 32 + 8 + h] + bias) : 0.f;
    const float x0 = dt0 * a, x1 = dt1 * a, s = x0 + x1;
    const float incl = wave_incl_scan(s, lane), excl = incl - s;
    ac0 = excl + x0; ac1 = excl + s; total = __uint_as_float(__builtin_amdgcn_readlane(__float_as_uint(incl), 63));
}

DI void ssda_item(int it, LAS unsigned char* lds, const bf16_t* P, const float* FDT, const float* cw, const float* cb, const float* dt_bias, const float* a_log, float* ST, float* CD) {
    int tid_ = threadIdx.x; asm volatile("" : "+v"(tid_));
    const int tid = tid_, wid = __builtin_amdgcn_readfirstlane(tid >> 6), lane = tid & 63, fr = lane & 15, fq = lane >> 4;
    LAS bf16_t* xsT = (LAS bf16_t*)lds;
    LAS bf16_t* BmT = (LAS bf16_t*)(lds + 34816);
    LAS float* wl = (LAS float*)(lds + 69632);
    const int g = it & 1, rest = it >> 1, c = rest % NBLK, b = rest / NBLK, t0 = 128 * c - 112;
    { float dt0, dt1, ac0, ac1, total; chunk_dt(FDT, dt_bias, a_log, b, t0, g * 8 + wid, lane, dt0, dt1, ac0, ac1, total);
      wl[wid * 128 + 2 * lane] = dt0 * __expf(total - ac0); wl[wid * 128 + 2 * lane + 1] = dt1 * __expf(total - ac1);
      if (lane == 63) CD[(b * NBLK + c) * 16 + g * 8 + wid] = __expf(total); }
#pragma unroll
    for (int i = 0; i < 2; ++i) { const int l = (wid & 1) * 64 + lane, cg8 = (wid >> 1) + 4 * i; float o[16]; conv16(P, b, t0 + l, 1024 + g * 128 + cg8 * 16, cw, cb, o);
#pragma unroll
      for (int e = 0; e < 16; ++e) BmT[(cg8 * 16 + e) * 136 + l] = f2bf(o[e]); }
    __syncthreads();
    bf16x8 af[4];
#pragma unroll
    for (int ks = 0; ks < 4; ++ks) af[ks] = *(const LAS bf16x8*)(BmT + (16 * wid + fr) * 136 + ks * 32 + fq * 8);
    for (int h8 = 0; h8 < 8; ++h8) {
        const int h = g * 8 + h8;
        LAS bf16_t* xb = xsT + (h8 & 1) * (64 * 136);
        { const int l = (wid & 1) * 64 + lane, cg4 = wid >> 1; float o[16]; conv16(P, b, t0 + l, h * 64 + cg4 * 16, cw, cb, o); const float w = wl[h8 * 128 + l];
#pragma unroll
          for (int e = 0; e < 16; ++e) xb[(cg4 * 16 + e) * 136 + l] = f2bf(o[e] * w); }
        __syncthreads();
        float* stp = ST + ((size_t)((b * NBLK + c) * 16 + h)) * 8192;
#pragma unroll
        for (int mt = 0; mt < 4; ++mt) { f32x4 acc = (f32x4){0.f, 0.f, 0.f, 0.f};
#pragma unroll
            for (int ks = 0; ks < 4; ++ks) { const bf16x8 xf = *(const LAS bf16x8*)(xb + (16 * mt + fr) * 136 + ks * 32 + fq * 8); acc = mfma16(af[ks], xf, acc); }
            *(f32x4*)(stp + (16 * mt + fr) * 128 + 16 * wid + 4 * fq) = acc; }
    }
}

DI void scan_phase(float* ST, const float* CD) {
    int tid_ = threadIdx.x; asm volatile("" : "+v"(tid_));
    for (int e4 = blockIdx.x * NTHR + tid_; e4 < NBATCH * 16 * 64 * 32; e4 += gridDim.x * NTHR) {
        const int n4 = e4 & 31, pp = (e4 >> 5) & 63, h = (e4 >> 11) & 15, b = e4 >> 15;
        f32x4 hs = (f32x4){0.f, 0.f, 0.f, 0.f};
#pragma unroll 11
        for (int c = 0; c < NBLK; ++c) { f32x4* ptr = (f32x4*)(ST + ((size_t)((b * NBLK + c) * 16 + h)) * 8192 + pp * 128 + n4 * 4); const f32x4 s = *ptr; *ptr = hs; const float d = CD[(b * NBLK + c) * 16 + h]; hs = hs * d + s; }
    }
}

DI void ssdc_item(int it, LAS unsigned char* lds, const bf16_t* P, const float* FDT, const float* cw, const float* cb, const float* dt_bias, const float* a_log, const float* d_skip,
                   const float* norm_w, const float* ST, bf16_t* Y) {
    int tid_ = threadIdx.x; asm volatile("" : "+v"(tid_));
    const int tid = tid_, wid = __builtin_amdgcn_readfirstlane(tid >> 6), lane = tid & 63, fr = lane & 15, fq = lane >> 4;
    LAS bf16_t* BmS = (LAS bf16_t*)lds;
    LAS bf16_t* CmS = (LAS bf16_t*)(lds + 34816);
    LAS bf16_t* xsT = (LAS bf16_t*)(lds + 69632);
    LAS bf16_t* prevS = (LAS bf16_t*)(lds + 87040);
    LAS float* dts = (LAS float*)(lds + 104448);
    LAS float* acss = (LAS float*)(lds + 108544);
    {
        const int g = it & 1, rest = it >> 1, c = rest % NBLK, b = rest / NBLK, t0 = 128 * c - 112;
        { float dt0, dt1, ac0, ac1, total; chunk_dt(FDT, dt_bias, a_log, b, t0, g * 8 + wid, lane, dt0, dt1, ac0, ac1, total);
          dts[wid * 128 + 2 * lane] = dt0; dts[wid * 128 + 2 * lane + 1] = dt1; acss[wid * 128 + 2 * lane] = ac0; acss[wid * 128 + 2 * lane + 1] = ac1; }
#pragma unroll
        for (int i = 0; i < 4; ++i) { const int l = (wid & 1) * 64 + lane, cgi = (wid >> 1) + 4 * i; float o[16];
            conv16(P, b, t0 + l, (cgi < 8 ? 1024 : 1280) + g * 128 + (cgi & 7) * 16, cw, cb, o);
            LAS bf16_t* dst = (cgi < 8 ? BmS : CmS) + l * 136 + (cgi & 7) * 16;
            u32x4 w0, w1; w0.x = cvt_pk_bf16(o[0], o[1]); w0.y = cvt_pk_bf16(o[2], o[3]); w0.z = cvt_pk_bf16(o[4], o[5]); w0.w = cvt_pk_bf16(o[6], o[7]);
            w1.x = cvt_pk_bf16(o[8], o[9]); w1.y = cvt_pk_bf16(o[10], o[11]); w1.z = cvt_pk_bf16(o[12], o[13]); w1.w = cvt_pk_bf16(o[14], o[15]);
            *(LAS u32x4*)dst = w0; *(LAS u32x4*)(dst + 8) = w1; }
        __syncthreads();
        bf16x8 cmf[4];
#pragma unroll
        for (int ks = 0; ks < 4; ++ks) cmf[ks] = *(const LAS bf16x8*)(CmS + (16 * wid + fr) * 136 + ks * 32 + fq * 8);
        f32x4 cbt[8];
#pragma unroll
        for (int nt = 0; nt < 8; ++nt) { cbt[nt] = (f32x4){0.f, 0.f, 0.f, 0.f};
            if (nt <= wid) {
#pragma unroll
                for (int ks = 0; ks < 4; ++ks) { const bf16x8 bmf = *(const LAS bf16x8*)(BmS + (16 * nt + fr) * 136 + ks * 32 + fq * 8); cbt[nt] = mfma16(bmf, cmf[ks], cbt[nt]); } } }
        const int li = 16 * wid + fr, t = t0 + li; const bool valid = t >= 0;
        const size_t grow = (size_t)b * LT + (valid ? t : 0);
        float ssq = 0.f;
        for (int h8 = 0; h8 < 8; ++h8) {
            const int h = g * 8 + h8;
            __syncthreads();
            { const int l = (wid & 1) * 64 + lane, cg4 = wid >> 1; float o[16]; conv16(P, b, t0 + l, h * 64 + cg4 * 16, cw, cb, o);
#pragma unroll
              for (int e = 0; e < 16; ++e) xsT[(cg4 * 16 + e) * 136 + l] = f2bf(o[e]); }
            { const float* stp = ST + ((size_t)((b * NBLK + c) * 16 + h)) * 8192;
#pragma unroll
              for (int i = 0; i < 4; ++i) { const int idx = tid + NTHR * i, pp = idx >> 5, n4 = idx & 31; const f32x4 v = *(const f32x4*)(stp + pp * 128 + n4 * 4);
                  u32x2 w; w.x = cvt_pk_bf16(v[0], v[1]); w.y = cvt_pk_bf16(v[2], v[3]); *(LAS u32x2*)(prevS + pp * 136 + n4 * 4) = w; } }
            u32x2 zw4[4];
#pragma unroll
            for (int pt = 0; pt < 4; ++pt) zw4[pt] = *(const u32x2*)(P + grow * NIN + C_Z + h * 64 + 16 * pt + 4 * fq);
            __syncthreads();
            const float acl = acss[h8 * 128 + li];
            f32x4 yacc[4], yoff[4];
#pragma unroll
            for (int pt = 0; pt < 4; ++pt) { yacc[pt] = (f32x4){0.f, 0.f, 0.f, 0.f}; yoff[pt] = (f32x4){0.f, 0.f, 0.f, 0.f}; }
#pragma unroll
            for (int ksp = 0; ksp < 4; ++ksp) {
                if (2 * ksp <= wid) {
                    const int s0 = 32 * ksp + 4 * fq, s1 = s0 + 16;
                    const f32x4 as0 = *(const LAS f32x4*)(acss + h8 * 128 + s0), as1 = *(const LAS f32x4*)(acss + h8 * 128 + s1);
                    const f32x4 d0 = *(const LAS f32x4*)(dts + h8 * 128 + s0), d1 = *(const LAS f32x4*)(dts + h8 * 128 + s1);
                    float g0[4], g1[4];
#pragma unroll
                    for (int j = 0; j < 4; ++j) {
                        g0[j] = (s0 + j <= li) ? cbt[2 * ksp][j] * __expf(acl - as0[j]) * d0[j] : 0.f;
                        g1[j] = (s1 + j <= li) ? cbt[2 * ksp + 1][j] * __expf(acl - as1[j]) * d1[j] : 0.f;
                    }
                    u32x4 gw; gw.x = cvt_pk_bf16(g0[0], g0[1]); gw.y = cvt_pk_bf16(g0[2], g0[3]); gw.z = cvt_pk_bf16(g1[0], g1[1]); gw.w = cvt_pk_bf16(g1[2], g1[3]);
                    const bf16x8 gf = __builtin_bit_cast(bf16x8, gw);
#pragma unroll
                    for (int pt = 0; pt < 4; ++pt) {
                        const s16x4 lo = *(const LAS s16x4*)(xsT + (16 * pt + fr) * 136 + s0), hi = *(const LAS s16x4*)(xsT + (16 * pt + fr) * 136 + s1);
                        const bf16x8 xf = __builtin_shufflevector(lo, hi, 0, 1, 2, 3, 4, 5, 6, 7);
                        yacc[pt] = mfma16(xf, gf, yacc[pt]);
                    }
                }
            }
#pragma unroll
            for (int ks = 0; ks < 4; ++ks)
#pragma unroll
                for (int pt = 0; pt < 4; ++pt) { const bf16x8 pf = *(const LAS bf16x8*)(prevS + (16 * pt + fr) * 136 + ks * 32 + fq * 8); yoff[pt] = mfma16(pf, cmf[ks], yoff[pt]); }
            const float eal = __expf(acl), dsk = d_skip[h];
#pragma unroll
            for (int pt = 0; pt < 4; ++pt) {
                const int p0 = 16 * pt + 4 * fq;
                const u32x2 zw = zw4[pt];
                float zz[4] = {__uint_as_float(zw.x << 16), __uint_as_float(zw.x & 0xffff0000u), __uint_as_float(zw.y << 16), __uint_as_float(zw.y & 0xffff0000u)};
                float gy[4];
#pragma unroll
                for (int j = 0; j < 4; ++j) { const float xv = bf2f(xsT[(p0 + j) * 136 + li]); const float y = yacc[pt][j] + eal * yoff[pt][j] + xv * dsk; gy[j] = y * silu_f(zz[j]); ssq += gy[j] * gy[j]; }
                if (valid) { u32x2 w; w.x = cvt_pk_bf16(gy[0], gy[1]); w.y = cvt_pk_bf16(gy[2], gy[3]); *(u32x2*)(Y + grow * D + 1024 + h * 64 + p0) = w; }
            }
        }
        ssq += shx(ssq, 16, lane); ssq += shx(ssq, 32, lane);
        const float rstd = __builtin_amdgcn_rsqf(ssq * (1.f / 512.f) + RMS_EPS);
        if (valid) {
            u32x2 yv[8][4];
#pragma unroll
            for (int h8 = 0; h8 < 8; ++h8)
#pragma unroll
                for (int pt = 0; pt < 4; ++pt) yv[h8][pt] = *(const u32x2*)(Y + grow * D + 1024 + (g * 8 + h8) * 64 + 16 * pt + 4 * fq);
#pragma unroll
            for (int h8 = 0; h8 < 8; ++h8)
#pragma unroll
                for (int pt = 0; pt < 4; ++pt) { const int ch = (g * 8 + h8) * 64 + 16 * pt + 4 * fq; const u32x2 w = yv[h8][pt]; const f32x4 nw = *(const f32x4*)(norm_w + ch);
                    u32x2 o; o.x = cvt_pk_bf16(__uint_as_float(w.x << 16) * rstd * nw[0], __uint_as_float(w.x & 0xffff0000u) * rstd * nw[1]);
                    o.y = cvt_pk_bf16(__uint_as_float(w.y << 16) * rstd * nw[2], __uint_as_float(w.y & 0xffff0000u) * rstd * nw[3]); *(u32x2*)(Y + grow * D + 1024 + ch) = o; }
        }
    }
}

DI void pool_item(int it, LAS unsigned char* lds, const bf16_t* P, const bf16_t* PWT, const float* pscale, bf16_t* Y) {
    int tid_ = threadIdx.x; asm volatile("" : "+v"(tid_));
    const int tid = tid_, wid = __builtin_amdgcn_readfirstlane(tid >> 6), lane = tid & 63, fr = lane & 15, fq = lane >> 4;
    LAS bf16_t* Us = (LAS bf16_t*)lds;
    LAS bf16_t* Xs = (LAS bf16_t*)(lds + 36608);
    LAS bf16_t* Ws = (LAS bf16_t*)(lds + 36608 + 34816);
    {
        const int g = it & 3, rest = it >> 2, blk = rest % NBLK, b = rest / NBLK, t0 = 128 * blk - 112;
        for (int cidx = tid; cidx < 143 * 16; cidx += NTHR) { const int j = cidx >> 4, ch = cidx & 15, t = t0 - 15 + j;
            u32x4 v = (u32x4){0u, 0u, 0u, 0u}; if (t >= 0) v = *(const u32x4*)(P + ((size_t)b * LT + t) * NIN + C_U + g * 128 + ch * 8);
            *(LAS u32x4*)(Us + j * 128 + ch * 8) = v; }
        for (int cidx = tid; cidx < 128 * 16; cidx += NTHR) { const int d = cidx >> 4, ch = cidx & 15; *(LAS u32x4*)(Ws + d * 136 + ch * 8) = *(const u32x4*)(PWT + (size_t)(g * 128 + d) * 128 + ch * 8); }
        __syncthreads();
        { const int cch = tid & 127, w = 2 << g, i0 = (tid >> 7) * 32;
          float s = 0.f;
          for (int j = 1; j < w; ++j) s += bf2f(Us[(i0 + 15 - j) * 128 + cch]);
          for (int k = 0; k < 32; ++k) { const int i = i0 + k, t = t0 + i;
              const float ucur = bf2f(Us[(i + 15) * 128 + cch]); s += ucur;
              const int cnt = t + 1 < w ? (t + 1 < 1 ? 1 : t + 1) : w;
              Xs[i * 136 + cch] = f2bf(s / (float)cnt - ucur);
              s -= bf2f(Us[(i + 15 - (w - 1)) * 128 + cch]); } }
        __syncthreads();
        bf16x8 xf[4];
#pragma unroll
        for (int ks = 0; ks < 4; ++ks) xf[ks] = *(const LAS bf16x8*)(Xs + (16 * wid + fr) * 136 + ks * 32 + fq * 8);
        const int t = t0 + 16 * wid + fr;
#pragma unroll
        for (int nt = 0; nt < 8; ++nt) { f32x4 acc = (f32x4){0.f, 0.f, 0.f, 0.f};
#pragma unroll
            for (int ks = 0; ks < 4; ++ks) { const bf16x8 wf = *(const LAS bf16x8*)(Ws + (16 * nt + fr) * 136 + ks * 32 + fq * 8); acc = mfma16(wf, xf[ks], acc); }
            if (t >= 0) { const int d0 = 16 * nt + 4 * fq; const f32x4 sc = *(const f32x4*)(pscale + g * 128 + d0);
                u32x2 w; w.x = cvt_pk_bf16(acc[0] * sc[0], acc[1] * sc[1]); w.y = cvt_pk_bf16(acc[2] * sc[2], acc[3] * sc[3]);
                *(u32x2*)(Y + ((size_t)b * LT + t) * D + 512 + g * 128 + d0) = w; } }
    }
}

DI void attn_item(int it, LAS unsigned char* lds, const bf16_t* P, const float* CC, bf16_t* Y) {
    int tid_ = threadIdx.x; asm volatile("" : "+v"(tid_));
    const int tid = tid_, wid = __builtin_amdgcn_readfirstlane(tid >> 6), lane = tid & 63, fr = lane & 15, fq = lane >> 4;
    LAS bf16_t* Ks = (LAS bf16_t*)lds;
    LAS bf16_t* Vt = (LAS bf16_t*)(lds + 18432);
    LAS float* cks = (LAS float*)(lds + 18432 + 17408);
    {
        const int jp = 16 - (it >> 5), bh = it & 31;
        const int b = bh >> 3, h = bh & 7;
        const size_t rowb = (size_t)b * LT;
        const int qi = 16 * wid + fr;
        int qbs[2]; qbs[0] = 2 * jp; qbs[1] = 2 * jp + 1 <= 32 ? 2 * jp + 1 : -1;
        const int ktmax = qbs[1] >= 0 ? qbs[1] : qbs[0];
        bf16x8 qf[2][2]; float cq[2]; bool qvalid[2]; size_t qrow[2];
        f32x4 oacc[2][4]; float mrun[2], lsum[2];
#pragma unroll
        for (int qq = 0; qq < 2; ++qq) {
            const int tq = 128 * qbs[qq] - 112 + qi; qvalid[qq] = (qbs[qq] >= 0) && (tq >= 0);
            qrow[qq] = rowb + (qvalid[qq] ? tq : 0);
            const bf16_t* qp = P + qrow[qq] * NIN + C_Q + h * 64 + fq * 8;
#pragma unroll
            for (int ks = 0; ks < 2; ++ks) { const u32x4 qw = *(const u32x4*)(qp + 32 * ks); u32x4 qs;
#pragma unroll
                for (int e = 0; e < 4; ++e) qs[e] = cvt_pk_bf16(__uint_as_float(qw[e] << 16) * 0.125f, __uint_as_float(qw[e] & 0xffff0000u) * 0.125f);
                qf[qq][ks] = __builtin_bit_cast(bf16x8, qs); }
            cq[qq] = CC[(size_t)bh * LT + (qvalid[qq] ? tq : 0)];
#pragma unroll
            for (int mt = 0; mt < 4; ++mt) oacc[qq][mt] = (f32x4){0.f, 0.f, 0.f, 0.f};
            mrun[qq] = -1e30f; lsum[qq] = 0.f;
        }
        u32x4 kreg[2], vreg[2]; float creg = 0.f;
#define ATT_PREFETCH(kt_) do { const int tb_ = 128 * (kt_) - 112; \
        _Pragma("unroll") for (int i_ = 0; i_ < 2; ++i_) { const int c_ = tid + NTHR * i_; \
            { const int key_ = c_ >> 3, dch_ = c_ & 7, t_ = tb_ + key_; kreg[i_] = (u32x4){0u, 0u, 0u, 0u}; if (t_ >= 0) kreg[i_] = *(const u32x4*)(P + (rowb + t_) * NIN + C_K + h * 64 + dch_ * 8); } \
            { const int key_ = c_ >> 3, dch_ = c_ & 7, t_ = tb_ + key_; vreg[i_] = (u32x4){0u, 0u, 0u, 0u}; if (t_ >= 0) vreg[i_] = *(const u32x4*)(P + (rowb + t_) * NIN + C_V + h * 64 + dch_ * 8); } } \
        if (tid < 128) { const int t_ = tb_ + tid; creg = t_ >= 0 ? CC[(size_t)bh * LT + t_] : 0.f; } } while (0)
        ATT_PREFETCH(0);
        for (int kt = 0; kt <= ktmax; ++kt) {
            __syncthreads();
#pragma unroll
            for (int i = 0; i < 2; ++i) { const int cidx = tid + NTHR * i;
                { const int key = cidx >> 3, dch = cidx & 7; *(LAS u32x4*)(Ks + key * 72 + dch * 8) = kreg[i]; }
                { const int key = cidx >> 3, dch = cidx & 7, kx = key ^ (4 * dch);
#pragma unroll
                  for (int q = 0; q < 4; ++q) { Vt[(dch * 8 + 2 * q) * 136 + kx] = (bf16_t)(vreg[i][q] & 0xffffu); Vt[(dch * 8 + 2 * q + 1) * 136 + kx] = (bf16_t)(vreg[i][q] >> 16); } } }
            if (tid < 128) cks[tid] = creg;
            __syncthreads();
            if (kt < ktmax) ATT_PREFETCH(kt + 1);
            const bool act0 = kt <= qbs[0], act1 = kt <= qbs[1];
            f32x4 sc[2][8];
#pragma unroll
            for (int nt = 0; nt < 8; ++nt) { const f32x4 ck = *(const LAS f32x4*)(cks + 16 * nt + 4 * fq);
                const bf16x8 kf0 = *(const LAS bf16x8*)(Ks + (16 * nt + fr) * 72 + fq * 8), kf1 = *(const LAS bf16x8*)(Ks + (16 * nt + fr) * 72 + 32 + fq * 8);
                if (act0) { f32x4 s = cq[0] - ck; s = mfma16(kf0, qf[0][0], s); s = mfma16(kf1, qf[0][1], s); sc[0][nt] = s; }
                if (act1) { f32x4 s = cq[1] - ck; s = mfma16(kf0, qf[1][0], s); s = mfma16(kf1, qf[1][1], s); sc[1][nt] = s; } }
            bf16x8 pf[2][4];
#pragma unroll
            for (int qq = 0; qq < 2; ++qq) {
                if (qq == 0 ? act0 : act1) {
                    const int qb = qbs[qq];
                    if (kt == 0 || kt == qb) {
#pragma unroll
                        for (int nt = 0; nt < 8; ++nt)
#pragma unroll
                            for (int j = 0; j < 4; ++j) { const int sl = 16 * nt + 4 * fq + j; const bool ok = (kt > 0 || sl >= 112) && (kt < qb || sl <= qi); sc[qq][nt][j] = ok ? sc[qq][nt][j] : -1e30f; }
                    }
                    float mloc = -1e30f;
#pragma unroll
                    for (int nt = 0; nt < 8; ++nt) mloc = fmaxf(mloc, fmaxf(fmaxf(sc[qq][nt][0], sc[qq][nt][1]), fmaxf(sc[qq][nt][2], sc[qq][nt][3])));
                    mloc = fmaxf(mloc, shx(mloc, 16, lane)); mloc = fmaxf(mloc, shx(mloc, 32, lane));
                    const float mnew = fmaxf(mrun[qq], mloc), alpha = __builtin_amdgcn_exp2f((mrun[qq] - mnew) * LOG2E), mneg = -mnew * LOG2E; mrun[qq] = mnew;
                    float psum = 0.f;
#pragma unroll
                    for (int nt = 0; nt < 8; ++nt)
#pragma unroll
                        for (int j = 0; j < 4; ++j) { const float pv = __builtin_amdgcn_exp2f(__builtin_fmaf(sc[qq][nt][j], LOG2E, mneg)); sc[qq][nt][j] = pv; psum += pv; }
                    lsum[qq] = lsum[qq] * alpha + psum;
#pragma unroll
                    for (int mt = 0; mt < 4; ++mt) oacc[qq][mt] = oacc[qq][mt] * alpha;
#pragma unroll
                    for (int s4 = 0; s4 < 4; ++s4) {
                        u32x4 pw; pw.x = cvt_pk_bf16(sc[qq][2 * s4][0], sc[qq][2 * s4][1]); pw.y = cvt_pk_bf16(sc[qq][2 * s4][2], sc[qq][2 * s4][3]); pw.z = cvt_pk_bf16(sc[qq][2 * s4 + 1][0], sc[qq][2 * s4 + 1][1]); pw.w = cvt_pk_bf16(sc[qq][2 * s4 + 1][2], sc[qq][2 * s4 + 1][3]);
                        pf[qq][s4] = __builtin_bit_cast(bf16x8, pw); }
                }
            }
#pragma unroll
            for (int s4 = 0; s4 < 4; ++s4)
#pragma unroll
                for (int mt = 0; mt < 4; ++mt) {
                    const int vsw = 4 * (2 * mt + (fr >> 3));
                    const s16x4 lo = *(const LAS s16x4*)(Vt + (16 * mt + fr) * 136 + ((32 * s4 + 4 * fq) ^ vsw)), hi = *(const LAS s16x4*)(Vt + (16 * mt + fr) * 136 + ((32 * s4 + 16 + 4 * fq) ^ vsw));
                    const bf16x8 vf = __builtin_shufflevector(lo, hi, 0, 1, 2, 3, 4, 5, 6, 7);
                    if (act0) oacc[0][mt] = mfma16(vf, pf[0][s4], oacc[0][mt]);
                    if (act1) oacc[1][mt] = mfma16(vf, pf[1][s4], oacc[1][mt]);
                }
        }
#undef ATT_PREFETCH
#pragma unroll
        for (int qq = 0; qq < 2; ++qq) {
            float ls = lsum[qq]; ls += shx(ls, 16, lane); ls += shx(ls, 32, lane);
            const float inv = 1.f / ls;
            if (qvalid[qq]) {
#pragma unroll
                for (int mt = 0; mt < 4; ++mt) { u32x2 w; w.x = cvt_pk_bf16(oacc[qq][mt][0] * inv, oacc[qq][mt][1] * inv); w.y = cvt_pk_bf16(oacc[qq][mt][2] * inv, oacc[qq][mt][3] * inv);
                    *(u32x2*)(Y + qrow[qq] * D + h * 64 + 16 * mt + 4 * fq) = w; }
            }
        }
    }
}

#define XB_TMO      128
#define XB_XCNT(j)  (256  + 64 * (j))
#define XB_XSUB(j)  (1280 + 64 * (j))
#define XB_XGEN(j)  (2304 + 64 * (j))
#define XB_TOP      3328
#define XB_TOPGEN   3392
#define XB_SPIN_CAP (1u << 20)
DI unsigned xb_ld(unsigned* p)              { return __hip_atomic_load(p, __ATOMIC_RELAXED, __HIP_MEMORY_SCOPE_AGENT); }
DI unsigned xb_add(unsigned* p, unsigned v) { return __hip_atomic_fetch_add(p, v, __ATOMIC_RELAXED, __HIP_MEMORY_SCOPE_AGENT); }
DI unsigned xb_xcc_id() { return (unsigned)__builtin_amdgcn_s_getreg((3 << 11) | 20) & 0xFu; }
#define XB_SPIN(cond, bar) do { unsigned _sp = 0; while (cond) { __builtin_amdgcn_s_sleep(1); \
    if ((++_sp & 255u) == 0u) { if (xb_ld(&(bar)[XB_TMO])) break; if (_sp > XB_SPIN_CAP) { atomicAdd(&(bar)[XB_TMO], 1u); break; } } } } while (0)
struct XcdBarrier { unsigned* bar; unsigned x; volatile LAS unsigned* st; };
DI XcdBarrier xcd_barrier_post(unsigned* bar, volatile LAS unsigned* st) {
    XcdBarrier b; b.bar = bar; b.x = xb_xcc_id(); b.st = st;
    if (threadIdx.x == 0) (void)xb_add(&bar[XB_XCNT(b.x)], 1u);
    return b;
}
DI void xcd_barrier_complete(unsigned* bar, unsigned x, unsigned& nloc, unsigned& nx) {
    const unsigned G = gridDim.x * gridDim.y * gridDim.z;
    unsigned sum, cnt, mine, sp = 0u;
    for (;;) {
        sum = 0u; cnt = 0u; mine = 0u;
#pragma unroll
        for (unsigned j = 0; j < 16; ++j) { const unsigned c = xb_ld(&bar[XB_XCNT(j)]); sum += c; cnt += (c > 0u) ? 1u : 0u; mine = (j == x) ? c : mine; }
        if (sum == G) break;
        __builtin_amdgcn_s_sleep(1);
        if ((++sp & 255u) == 0u) { if (xb_ld(&bar[XB_TMO])) break; if (sp > XB_SPIN_CAP) { atomicAdd(&bar[XB_TMO], 1u); break; } }
    }
    nloc = mine > 0u ? mine : 1u; nx = cnt > 0u ? cnt : 1u;
}
DI void xcd_barrier(const XcdBarrier& b) {
    asm volatile("s_waitcnt vmcnt(0)" ::: "memory");
    __syncthreads();
    if (threadIdx.x == 0) {
        unsigned* bar = b.bar;
        __builtin_amdgcn_s_waitcnt(0);
        unsigned nloc = b.st[0], nx = b.st[1];
        if (nloc == 0u) { xcd_barrier_complete(bar, b.x, nloc, nx); b.st[0] = nloc; b.st[1] = nx; }
        const unsigned old = xb_add(&bar[XB_XSUB(b.x)], 1u);
        const unsigned gen = old / nloc;
        if (old + 1u == (gen + 1u) * nloc) {
            __builtin_amdgcn_fence(__ATOMIC_RELEASE, "agent");
            asm volatile("s_waitcnt vmcnt(0)" ::: "memory");
            const unsigned og = xb_add(&bar[XB_TOP], 1u);
            const unsigned tg = og / nx;
            if (og + 1u == (tg + 1u) * nx) xb_add(&bar[XB_TOPGEN], 1u);
            else XB_SPIN(xb_ld(&bar[XB_TOPGEN]) == tg, bar);
            __builtin_amdgcn_fence(__ATOMIC_ACQUIRE, "agent");
            xb_add(&bar[XB_XGEN(b.x)], 1u);
            asm volatile("s_waitcnt vmcnt(0)" ::: "memory");
        } else {
            XB_SPIN(xb_ld(&bar[XB_XGEN(b.x)]) == gen, bar);
            __builtin_amdgcn_fence(__ATOMIC_ACQUIRE, "agent");
            asm volatile("s_waitcnt vmcnt(0)" ::: "memory");
        }
    }
    __syncthreads();
}

constexpr int NSTEP_L = 9, NPHASE = 1 + NSTEP_L * DEPTH + 1;

__global__ void __launch_bounds__(NTHR) mega(Params p) {
    extern __shared__ __attribute__((aligned(16))) unsigned char lds_raw[];
    LAS unsigned char* lds = (LAS unsigned char*)lds_raw;
    cg::grid_group grid = cg::this_grid();
    LAS unsigned* stw = (LAS unsigned*)(lds + LDS_BYTES - 32);
    if (threadIdx.x == 0) { stw[0] = 0u; stw[1] = 0u; }
    __syncthreads();
    const XcdBarrier xb = xcd_barrier_post((unsigned*)(p.ws + WS_BAR), (volatile LAS unsigned*)stw);
    for (int ph = p.ph_lo; ph < p.ph_hi; ++ph) {
        if (p.ph_lo < 0) grid.sync();
        if (ph > p.ph_lo) xcd_barrier(xb);
        size_t zoff = 0; asm volatile("" : "+s"(zoff));
        unsigned char* ws = p.ws + zoff;
        float* H32 = (float*)(ws + WS_H32); bf16_t* H16 = (bf16_t*)(ws + WS_H16); float* ST = (float*)(ws + WS_H16);
        bf16_t* ACT = (bf16_t*)(ws + WS_BIG); bf16_t* PROJ = (bf16_t*)(ws + WS_BIG); bf16_t* Y = (bf16_t*)(ws + WS_BIG + SZ_PROJ);
        float* FDT = (float*)(ws + WS_FDT); float* CC = (float*)(ws + WS_CC); float* CD = (float*)(ws + WS_CD);
        float* STAT = (float*)(ws + WS_STAT);
        if (ph == 0) { prep_phase(lds, p); continue; }
        if (ph == NPHASE - 1) { ln_phase(H32, H16, p.in[23] + (DEPTH - 1) * D, p.in[24] + (DEPTH - 1) * D, p.out); continue; }
        const int l = (ph - 1) / NSTEP_L, s = (ph - 1) % NSTEP_L;
#ifdef REP_S
        for (int rep = 0; rep < ((s == REP_S) ? 2 : 1); ++rep) {
        if (rep) xcd_barrier(xb);
#else
        { const int rep = 0; (void)rep;
#endif
        switch (s) {
        case 0: case 7: {
            const int f = (s == 7), q = l * 2 + f, stg = 3 * l + 2 * f;
            const float* st = stg ? STAT + (size_t)stg * R * 2 : nullptr;
            const bf16_t* Wt = (const bf16_t*)(ws + WS_WGU + (size_t)q * SZ_WGU);
            const float* GW = (const float*)(ws + WS_GWGU) + (size_t)q * 2 * FF; const float* BW = (const float*)(ws + WS_BWGU) + (size_t)q * 2 * FF;
            pg8::Gemm g{H16, Wt, 2 * FF, D}; pg8::StaticOrder S; S.init(2 * FF, gridDim.x, blockIdx.x);
            pg8::EpiGU E{ACT, st, GW, BW};
            pg8::gemm_phase<pg8::EpiGU>(lds, g, S, E);
            skinny_phase<0>(lds, H16, D, Wt, FF / 16, ACT, nullptr, 0.f, st, GW, BW, nullptr, nullptr, nullptr, nullptr);
        } break;
        case 1: case 8: {
            const int f = (s == 8), q = l * 2 + f, stg = 3 * l + 2 * f;
            const float* st = stg ? STAT + (size_t)stg * R * 2 : nullptr;
            const float* lg = f ? p.in[18] + l * D : (l ? p.in[23] + (l - 1) * D : nullptr);
            const float* lb = f ? p.in[19] + l * D : (l ? p.in[24] + (l - 1) * D : nullptr);
            float* sto = STAT + (size_t)(stg + 1) * R * 2;
            const bf16_t* Wt = (const bf16_t*)(ws + WS_WDN + (size_t)q * SZ_WDN);
            pg8::Gemm g{ACT, Wt, D, FF}; pg8::StaticOrder S; S.init(D, gridDim.x, blockIdx.x);
            pg8::EpiRes<true> E{H32, H16, st, lg, lb, sto};
            pg8::gemm_phase<pg8::EpiRes<true>>(lds, g, S, E);
            skinny_phase<1>(lds, ACT, FF, Wt, D / 32, nullptr, H32, 0.5f, st, nullptr, nullptr, lg, lb, sto, H16);
        } break;
        case 2: {
            const float* st = STAT + (size_t)(3 * l + 1) * R * 2;
            const bf16_t* Wt = (const bf16_t*)(ws + WS_WIN + (size_t)l * SZ_WIN);
            const float* GW = (const float*)(ws + WS_GWIN) + (size_t)l * NIN; const float* BW = (const float*)(ws + WS_BWIN) + (size_t)l * NIN;
            pg8::Gemm g{H16, Wt, NIN, D}; pg8::StaticOrder S; S.init(NIN, gridDim.x, blockIdx.x);
            pg8::EpiWin E{PROJ, FDT, st, GW, BW};
            pg8::gemm_phase<pg8::EpiWin>(lds, g, S, E);
            skinny_phase<2>(lds, H16, D, Wt, NIN / 32, PROJ, FDT, 0.f, st, GW, BW, nullptr, nullptr, nullptr, nullptr);
        } break;
        case 3: {
            unsigned* ctr = (unsigned*)(ws + WS_Q) + ph + 32 * rep;
            LAS int* slot = (LAS int*)(lds + LDS_BYTES - 16);
            for (;;) {
                __syncthreads();
                if (threadIdx.x == 0) *slot = (int)atomicAdd(ctr, 1u);
                __syncthreads();
                const int it = *slot;
                constexpr int NSA = NBATCH * NBLK * 2, NPL = NBATCH * NBLK * 4;
                if (it >= NSA + NPL + 32) break;
                if (it < NSA) ssda_item(it, lds, PROJ, FDT, p.in[11] + l * 4 * 1536, p.in[12] + l * 1536, p.in[13] + l * 16, p.in[14] + l * 16, ST, CD);
                else if (it < NSA + NPL) pool_item(it - NSA, lds, PROJ, (const bf16_t*)(ws + WS_PWT) + (size_t)l * 4 * 128 * 128, p.in[10] + l * 512, Y);
                else cumsum_item(lds, FDT, p.in[8] + l * 8, CC, it - NSA - NPL);
            }
        } break;
        case 4:
            scan_phase(ST, CD);
            break;
        case 5: {
            unsigned* ctr = (unsigned*)(ws + WS_Q) + ph + 32 * rep;
            LAS int* slot = (LAS int*)(lds + LDS_BYTES - 16);
            for (;;) {
                __syncthreads();
                if (threadIdx.x == 0) *slot = (int)atomicAdd(ctr, 1u);
                __syncthreads();
                const int it = *slot;
                constexpr int NSC = NBATCH * NBLK * 2, NAT = 32 * 17;
                if (it >= NSC + NAT) break;
                if (it < NSC) ssdc_item(it, lds, PROJ, FDT, p.in[11] + l * 4 * 1536, p.in[12] + l * 1536, p.in[13] + l * 16, p.in[14] + l * 16, p.in[15] + l * 16, p.in[16] + l * 1024, ST, Y);
                else attn_item(it - NSC, lds, PROJ, CC, Y);
            }
        } break;
        case 6: {
            const float* st = STAT + (size_t)(3 * l + 1) * R * 2; float* sto = STAT + (size_t)(3 * l + 2) * R * 2;
            const bf16_t* Wt = (const bf16_t*)(ws + WS_WOUT + (size_t)l * SZ_WOUT);
            pg8::Gemm g{Y, Wt, D, D}; pg8::StaticOrder S; S.init(D, gridDim.x, blockIdx.x);
            pg8::EpiRes<false> E{H32, H16, st, p.in[5] + l * D, p.in[6] + l * D, sto};
            pg8::gemm_phase<pg8::EpiRes<false>>(lds, g, S, E);
            skinny_phase<1>(lds, Y, D, Wt, D / 32, nullptr, H32, 1.0f, st, nullptr, nullptr, p.in[5] + l * D, p.in[6] + l * D, sto, H16);
        } break;
        }
        }
    }
}

extern "C" void kernel_launch(void* const* d_in, const int* in_sizes, int n_in, void* d_out, int out_size, void* d_ws, size_t ws_size, hipStream_t stream) {
    static int grid = 0;
    if (grid == 0) {
        if (n_in != 25 || ws_size < WS_END) { fprintf(stderr, "kernel_launch: need 25 inputs and %zu bytes of workspace (got %d, %zu)\n", (size_t)WS_END, n_in, ws_size); grid = -1; return; }
        int dev = 0, cus = 0, per_cu = 0;
        (void)hipGetDevice(&dev);
        (void)hipDeviceGetAttribute(&cus, hipDeviceAttributeMultiprocessorCount, dev);
        if (hipFuncSetAttribute((const void*)mega, hipFuncAttributeMaxDynamicSharedMemorySize, LDS_BYTES) != hipSuccess) fprintf(stderr, "kernel_launch: hipFuncSetAttribute failed\n");
        if (hipOccupancyMaxActiveBlocksPerMultiprocessor(&per_cu, (const void*)mega, NTHR, LDS_BYTES) != hipSuccess || per_cu < 1) { fprintf(stderr, "kernel_launch: occupancy query says %d\n", per_cu); per_cu = 1; }
        (void)hipGetLastError();
        grid = cus * per_cu;
        if (grid != 256) { fprintf(stderr, "kernel_launch: this build's per-phase folded-LN tables assume a 256-workgroup grid (one per CU of a 256-CU device); got %d\n", grid); grid = -1; return; }
    }
    if (grid < 0) return;
    (void)hipMemsetAsync((unsigned char*)d_ws + WS_ZERO, 0, ZERO_BYTES, stream);
    Params p{};
    for (int i = 0; i < 25; ++i) p.in[i] = (const float*)d_in[i];
    p.out = (float*)d_out; p.ws = (unsigned char*)d_ws;
#if PER_PHASE_LAUNCH
    for (int ph = 0; ph < NPHASE; ++ph) { p.ph_lo = ph; p.ph_hi = ph + 1; hipLaunchKernelGGL(mega, dim3(grid), dim3(NTHR), LDS_BYTES, stream, p); }
#else
    p.ph_lo = 0; p.ph_hi = NPHASE;
    void* args[] = {&p};
    hipError_t e = hipLaunchCooperativeKernel((const void*)mega, dim3(grid), dim3(NTHR), args, LDS_BYTES, stream);
    if (e != hipSuccess) fprintf(stderr, "cooperative launch failed: %s (grid %d)\n", hipGetErrorString(e), grid);
#endif
}
```

```cpp
#include <hip/hip_runtime.h>
#include <hip/hip_cooperative_groups.h>
#include <cstdio>
namespace cg = cooperative_groups;

#ifndef PER_PHASE_LAUNCH
#define PER_PHASE_LAUNCH 0
#endif

#define LAS __attribute__((address_space(3)))
#define DI __device__ __forceinline__
typedef unsigned short bf16_t;
typedef short bf16x8 __attribute__((ext_vector_type(8)));
typedef short s16x4 __attribute__((ext_vector_type(4)));
typedef float f32x4 __attribute__((ext_vector_type(4)));
typedef unsigned u32x4 __attribute__((ext_vector_type(4)));
typedef unsigned u32x2 __attribute__((ext_vector_type(2)));

constexpr int D = 2048, NBATCH = 4, SEQ = 4096, NMETA = 16, LT = SEQ + NMETA  , R = NBATCH * LT  ;
constexpr int FF = 5632, NIN = 4864  , NBLK = 33, NTHR = 512, DEPTH = 2;
constexpr int C_Q = 0, C_K = 512, C_V = 1024, C_U = 1536, C_Z = 2048, C_X = 3072, C_F = 4608;
constexpr float ALPHA = 1.41421356237309515f, LN_EPS = 1e-5f, RMS_EPS = 1e-5f, LOG2E = 1.4426950408889634f;
constexpr int LDS_BYTES = 159744;

constexpr size_t SZ_WGU = (size_t)2 * FF * D * 2, SZ_WDN = (size_t)D * FF * 2, SZ_WIN = (size_t)NIN * D * 2, SZ_WOUT = (size_t)D * D * 2, SZ_PWT = (size_t)4 * 128 * 128 * 2;
constexpr size_t WS_WGU = 0;
constexpr size_t WS_WDN = WS_WGU + 4 * SZ_WGU;
constexpr size_t WS_WIN = WS_WDN + 4 * SZ_WDN;
constexpr size_t WS_WOUT = WS_WIN + 2 * SZ_WIN;
constexpr size_t WS_PWT = WS_WOUT + 2 * SZ_WOUT;
constexpr size_t WS_H32 = WS_PWT + 2 * SZ_PWT;
constexpr size_t WS_H16 = WS_H32 + (size_t)R * D * 4;
constexpr size_t SZ_ST = (size_t)NBATCH * NBLK * 16 * 64 * 128 * 4;
constexpr size_t WS_BIG = WS_H16 + SZ_ST;
constexpr size_t SZ_PROJ = (size_t)R * NIN * 2, SZ_Y = (size_t)R * D * 2;
constexpr size_t WS_FDT = WS_BIG + SZ_PROJ + SZ_Y;
constexpr size_t WS_CC = WS_FDT + (size_t)R * 32 * 4;
constexpr size_t WS_CD = WS_CC + (size_t)NBATCH * 8 * LT * 4;
constexpr size_t WS_ZERO = WS_CD + (size_t)NBATCH * NBLK * 16 * 4 + 256;
constexpr size_t WS_Q = WS_ZERO;
constexpr size_t WS_STAT = WS_Q + 256;
constexpr size_t WS_GWGU = WS_STAT + (size_t)7 * R * 2 * 4;
constexpr size_t WS_BWGU = WS_GWGU + (size_t)4 * 2 * FF * 4;
constexpr size_t WS_GWIN = WS_BWGU + (size_t)4 * 2 * FF * 4;
constexpr size_t WS_BWIN = WS_GWIN + (size_t)2 * NIN * 4;
constexpr size_t WS_BAR = WS_BWIN + (size_t)2 * NIN * 4;
constexpr size_t WS_END = WS_BAR + 3456 * 4 + 256 - (3456 * 4) % 256;
constexpr size_t ZERO_BYTES = WS_END - WS_ZERO;
static_assert((size_t)R * FF * 2 <= SZ_PROJ + SZ_Y, "ACT fits");
static_assert(SZ_ST >= (size_t)R * D * 2, "H16 fits");

typedef float f32x2c __attribute__((ext_vector_type(2)));
typedef __bf16 bf16x2c __attribute__((ext_vector_type(2)));
DI unsigned cvt_pk_bf16(float lo, float hi) { const f32x2c v = {lo, hi}; return __builtin_bit_cast(unsigned, __builtin_convertvector(v, bf16x2c)); }
DI float bf2f(bf16_t v) { return __uint_as_float(((unsigned)v) << 16); }
DI bf16_t f2bf(float f) { return (bf16_t)(cvt_pk_bf16(f, 0.f) & 0xffffu); }
DI float silu_f(float x) { return x * __builtin_amdgcn_rcpf(1.f + __expf(-x)); }
DI float softplus_f(float x) { return x > 20.f ? x : __logf(1.f + __expf(x)); }
DI float shx(float v, int mask, int lane) { return __uint_as_float((unsigned)__builtin_amdgcn_ds_bpermute((lane ^ mask) << 2, (int)__float_as_uint(v))); }
DI float wave_sum(float v, int lane) {
#pragma unroll
    for (int o = 1; o < 64; o <<= 1) v += shx(v, o, lane);
    return v;
}
DI float wave_incl_scan(float x, int lane) {
#pragma unroll
    for (int o = 1; o < 64; o <<= 1) { const float v = __uint_as_float((unsigned)__builtin_amdgcn_ds_bpermute((lane - o) << 2, (int)__float_as_uint(x))); if (lane >= o) x += v; }
    return x;
}
DI f32x4 mfma16(bf16x8 a, bf16x8 b, f32x4 c) { return __builtin_amdgcn_mfma_f32_16x16x32_bf16(a, b, c, 0, 0, 0); }
DI int memrow_meta(int r) { return (r >> 4) * LT + (r & 15); }
#define RLF(v, k) __uint_as_float(__builtin_amdgcn_readlane(__float_as_uint(v), (k)))
#define LDS_WAIT() asm volatile("s_waitcnt lgkmcnt(0)" ::: "memory")
typedef float f32x2 __attribute__((ext_vector_type(2)));
DI f32x2 row_stats(const float* st, size_t row) {
    float rstd = 1.f, mu = 0.f;
    if (st) { const f32x2 sq = *(const f32x2*)(st + row * 2); mu = sq.x * (1.f / D); const float var = fmaxf(sq.y * (1.f / D) - mu * mu, 0.f); rstd = __builtin_amdgcn_rsqf(var + LN_EPS); }
    return (f32x2){rstd, mu};
}

namespace pg8 {
constexpr int BM = 256, BK = 64, HALF = 128, HTB = HALF * BK * 2, NXCD = 8, WGM = 8;
DI int lds_byte(int r, int c) { const int st = (r >> 4) * 2 + (c >> 5), rr = r & 15, cc = c & 31, ob = rr * 64 + cc * 2; return st * 1024 + (ob ^ (((ob >> 9) & 1) << 5)); }
DI void stage_rc(int b, int& Rr, int& Cc) { const int st = b / 1024, sb = b % 1024, swz = sb ^ (((sb >> 9) & 1) << 5); Rr = (st >> 1) * 16 + swz / 64; Cc = (st & 1) * 32 + (swz % 64) / 2; }
DI int perm32(int rho) { const int n = rho >> 4, i = rho & 15; return 8 * (i >> 2) + 4 * n + (i & 3); }
struct Unit { int pm, pn; };
struct Gemm { const bf16_t* A; const bf16_t* Bt; int N, K; };
DI int rowbase(int pm) { return (pm >> 4) * LT + NMETA + (pm & 15) * 256; }
struct StaticOrder {
    int nM, nN, nwg, G, c;
    DI void init(int N, int G_, int c_) { nM = 64; nN = N / BM; nwg = nM * nN; G = G_; c = c_; }
    DI bool next(int i, Unit& u) const {
        const int L = __builtin_amdgcn_readfirstlane(i * G + c); if (L >= nwg) return false;
        int wgid = L; { const int q = nwg / NXCD, r = nwg % NXCD, xcd = wgid % NXCD, off = wgid / NXCD; wgid = (xcd < r ? xcd * (q + 1) : r * (q + 1) + (xcd - r) * q) + off; }
        const int nig = WGM * nN, gid = wgid / nig, fm = gid * WGM, gsz = (nM - fm) < WGM ? (nM - fm) : WGM;
        u.pm = fm + ((wgid % nig) % gsz); u.pn = (wgid % nig) / gsz; return true;
    }
};

constexpr int TAB_OFF = 131072, TABC_OFF = 131072 + 2048, TABC_BYTES = 2048, TAB_MAXU = 11;
struct EpiGU {
    static constexpr bool PERM = true, TAB = true; bf16_t* O; const float* ST; const float* GW; const float* BW;
    DI f32x2 row_fetch(int pm, int tid) const { const f32x2 rs = row_stats(ST, (size_t)(rowbase(pm) + (tid & 255))); return (f32x2){rs.x, rs.x * rs.y}; }
    DI float col_fetch(int pn, int tid) const { return tid < 256 ? GW[pn * 256 + tid] : BW[pn * 256 + tid - 256]; }
    DI void operator()(const f32x4 (&acc)[2][2][4][2], const Unit& u, int wr, int wc, int fr, int fq, const LAS unsigned char* tabR, const LAS unsigned char* tabC) const {
        asm volatile("" : "+v"(fr), "+v"(fq));
        const int row0 = rowbase(u.pm) + wr * 64 + fr, col0 = u.pn * 128 + wc * 32 + 8 * fq, lc0 = wc * 32 + 8 * fq;
        const LAS f32x2* tr = (const LAS f32x2*)tabR; const LAS float* tg = (const LAS float*)tabC; const LAS float* tb = (const LAS float*)(tabC + 1024);
        f32x4 gw[2][2], bw[2][2];
#pragma unroll
        for (int bj = 0; bj < 2; ++bj)
#pragma unroll
            for (int n = 0; n < 2; ++n) { gw[bj][n] = *(const LAS f32x4*)(tg + lc0 + bj * HALF + 4 * n); bw[bj][n] = *(const LAS f32x4*)(tb + lc0 + bj * HALF + 4 * n); }
#pragma unroll
        for (int ai = 0; ai < 2; ++ai)
#pragma unroll
            for (int m = 0; m < 4; ++m) {
                const size_t row = (size_t)(row0 + ai * HALF + m * 16);
                const f32x2 rs = tr[ai * HALF + wr * 64 + m * 16 + fr]; const float rstd = rs.x, rm = rs.y;
                bf16_t* rowp = O + row * FF + col0;
                const f32x4 g0 = acc[ai][0][m][0] * rstd - gw[0][0] * rm + bw[0][0], g1 = acc[ai][0][m][1] * rstd - gw[0][1] * rm + bw[0][1];
                const f32x4 u0 = acc[ai][1][m][0] * rstd - gw[1][0] * rm + bw[1][0], u1 = acc[ai][1][m][1] * rstd - gw[1][1] * rm + bw[1][1];
                f32x4 v0, v1;
#pragma unroll
                for (int j = 0; j < 4; ++j) { v0[j] = silu_f(g0[j]) * u0[j]; v1[j] = silu_f(g1[j]) * u1[j]; }
                u32x4 w; w.x = cvt_pk_bf16(v0[0], v0[1]); w.y = cvt_pk_bf16(v0[2], v0[3]); w.z = cvt_pk_bf16(v1[0], v1[1]); w.w = cvt_pk_bf16(v1[2], v1[3]);
                *(u32x4*)rowp = w;
            }
    }
};
template <bool HALFC> struct EpiRes {
    static constexpr bool PERM = false, TAB = false; static constexpr float coef = HALFC ? 0.5f : 1.0f; float* H; bf16_t* H16; const float* STin; const float* lg; const float* lb; float* STout;
    DI f32x2 row_fetch(int, int) const { return (f32x2){0.f, 0.f}; }
    DI float col_fetch(int, int) const { return 0.f; }
    DI void operator()(const f32x4 (&acc)[2][2][4][2], const Unit& u, int wr, int wc, int fr, int fq, const LAS unsigned char*, const LAS unsigned char*) const {
        asm volatile("" : "+v"(fr), "+v"(fq));
        const int row0 = rowbase(u.pm) + wr * 64 + fr, col0 = u.pn * BM + wc * 32 + 4 * fq;
        const bool has = STin != nullptr;
#pragma unroll
        for (int ai = 0; ai < 2; ++ai)
#pragma unroll
            for (int mp = 0; mp < 2; ++mp) {
                f32x4 hv[2][2][2]; f32x2 rsv2[2]; f32x4 gq[2][2], bq[2][2];
#pragma unroll
                for (int mm = 0; mm < 2; ++mm) { rsv2[mm] = row_stats(STin, (size_t)(row0 + ai * HALF + (2 * mp + mm) * 16));
                    const float* rowp = H + (size_t)(row0 + ai * HALF + (2 * mp + mm) * 16) * D + col0;
#pragma unroll
                    for (int bj = 0; bj < 2; ++bj)
#pragma unroll
                        for (int n = 0; n < 2; ++n) hv[mm][bj][n] = *(const f32x4*)(rowp + bj * HALF + n * 16); }
#pragma unroll
                for (int bj = 0; bj < 2; ++bj)
#pragma unroll
                    for (int n = 0; n < 2; ++n) {
                        gq[bj][n] = (f32x4){1.f, 1.f, 1.f, 1.f}; bq[bj][n] = (f32x4){0.f, 0.f, 0.f, 0.f};
                        if (has) { gq[bj][n] = *(const f32x4*)(lg + col0 + bj * HALF + n * 16); bq[bj][n] = *(const f32x4*)(lb + col0 + bj * HALF + n * 16); } }
#pragma unroll
                for (int mm = 0; mm < 2; ++mm) {
                    const int m = 2 * mp + mm;
                    const size_t row = (size_t)(row0 + ai * HALF + m * 16);
                    const float rstd = rsv2[mm].x, mu = rsv2[mm].y;
                    float* rowp = H + row * D + col0; bf16_t* row16 = H16 + row * D + col0;
                    float ps = 0.f, pq = 0.f;
#pragma unroll
                    for (int bj = 0; bj < 2; ++bj)
#pragma unroll
                        for (int n = 0; n < 2; ++n) {
                            const f32x4 h = (hv[mm][bj][n] - mu) * rstd * gq[bj][n] + bq[bj][n];
                            const f32x4 xn = h * ALPHA + acc[ai][bj][m][n] * coef;
                            *(f32x4*)(rowp + bj * HALF + n * 16) = xn;
                            u32x2 w; w.x = cvt_pk_bf16(xn[0], xn[1]); w.y = cvt_pk_bf16(xn[2], xn[3]); *(u32x2*)(row16 + bj * HALF + n * 16) = w;
                            ps += (xn[0] + xn[1]) + (xn[2] + xn[3]); pq += (xn[0] * xn[0] + xn[1] * xn[1]) + (xn[2] * xn[2] + xn[3] * xn[3]);
                        }
                    ps += shx(ps, 16, (fr + 16 * fq)); ps += shx(ps, 32, (fr + 16 * fq)); pq += shx(pq, 16, (fr + 16 * fq)); pq += shx(pq, 32, (fr + 16 * fq));
                    if (fq == 0) { unsafeAtomicAdd(STout + row * 2, ps); unsafeAtomicAdd(STout + row * 2 + 1, pq); }
                }
            }
    }
};
struct EpiWin {
    static constexpr bool PERM = true, TAB = true; bf16_t* P; float* FDT; const float* ST; const float* GW; const float* BW;
    DI f32x2 row_fetch(int pm, int tid) const { const f32x2 rs = row_stats(ST, (size_t)(rowbase(pm) + (tid & 255))); return (f32x2){rs.x, rs.x * rs.y}; }
    DI float col_fetch(int pn, int tid) const { return tid < 256 ? GW[pn * 256 + tid] : BW[pn * 256 + tid - 256]; }
    DI void operator()(const f32x4 (&acc)[2][2][4][2], const Unit& u, int wr, int wc, int fr, int fq, const LAS unsigned char* tabR, const LAS unsigned char* tabC) const {
        asm volatile("" : "+v"(fr), "+v"(fq));
        const int row0 = rowbase(u.pm) + wr * 64 + fr, col0 = u.pn * BM + wc * 32 + 8 * fq, lc0 = wc * 32 + 8 * fq;
        const LAS f32x2* tr = (const LAS f32x2*)tabR; const LAS float* tg = (const LAS float*)tabC; const LAS float* tb = (const LAS float*)(tabC + 1024);
        f32x4 gw[2][2], bw[2][2];
#pragma unroll
        for (int bj = 0; bj < 2; ++bj)
#pragma unroll
            for (int n = 0; n < 2; ++n) { gw[bj][n] = *(const LAS f32x4*)(tg + lc0 + bj * HALF + 4 * n); bw[bj][n] = *(const LAS f32x4*)(tb + lc0 + bj * HALF + 4 * n); }
#pragma unroll
        for (int ai = 0; ai < 2; ++ai)
#pragma unroll
            for (int m = 0; m < 4; ++m) {
                const size_t row = (size_t)(row0 + ai * HALF + m * 16);
                const f32x2 rs = tr[ai * HALF + wr * 64 + m * 16 + fr]; const float rstd = rs.x, rm = rs.y;
                bf16_t* rowp = P + row * NIN + col0;
                f32x4 v[2][2];
#pragma unroll
                for (int bj = 0; bj < 2; ++bj) {
                    v[bj][0] = acc[ai][bj][m][0] * rstd - gw[bj][0] * rm + bw[bj][0]; v[bj][1] = acc[ai][bj][m][1] * rstd - gw[bj][1] * rm + bw[bj][1];
                    u32x4 w; w.x = cvt_pk_bf16(v[bj][0][0], v[bj][0][1]); w.y = cvt_pk_bf16(v[bj][0][2], v[bj][0][3]); w.z = cvt_pk_bf16(v[bj][1][0], v[bj][1][1]); w.w = cvt_pk_bf16(v[bj][1][2], v[bj][1][3]);
                    *(u32x4*)(rowp + bj * HALF) = w;
                }
                if (u.pn == 18 && wc == 0 && fq < 3) { float* f = FDT + row * 32 + 8 * fq; *(f32x4*)f = v[0][0]; *(f32x4*)(f + 4) = v[0][1]; }
            }
    }
};

#ifndef PG8_SP2
#define PG8_SP2 true
#endif
#ifndef PG8_ALIGN
#define PG8_ALIGN true
#endif
template <class Epi, bool SP2 = PG8_SP2, bool ALIGN_EPI = PG8_ALIGN>
DI void gemm_phase(LAS unsigned char* lds, const Gemm g, const StaticOrder& S, const Epi& E) {
    int tid_ = threadIdx.x; asm volatile("" : "+v"(tid_));
    const int tid = tid_, wid = __builtin_amdgcn_readfirstlane(tid >> 6), lane = tid & 63, wr = wid >> 2, wc = wid & 3, fr = lane & 15, fq = lane >> 4;
    const int K = g.K, nt = K / BK;
    unsigned voffA[2], voffB[2];
#pragma unroll
    for (int i = 0; i < 2; ++i) { int Rr, Cc; stage_rc(tid * 16 + i * 8192, Rr, Cc); const int Rb = Epi::PERM ? ((Rr & ~31) + perm32(Rr & 31)) : Rr;
        voffA[i] = (unsigned)(Rr * K + Cc) * 2u; voffB[i] = (unsigned)(Rb * K + Cc) * 2u; }
    const size_t kstep = (size_t)(BK * 2);
    const size_t hstep = (size_t)HALF * K * 2;
    const size_t tstep = 2 * hstep;
    const size_t rstep = (size_t)K * 2;
    const unsigned ldsw = (unsigned)wid * 1024u;
    const int aoff = lds_byte(wr * 64 + fr, fq * 8), boff = lds_byte(wc * 32 + fr, fq * 8);
#define PG8_SA(b, h) (((b) * 2 + (h)) * HTB)
#define PG8_SB(b, h) ((4 + (b) * 2 + (h)) * HTB)
#define PG8_STAGE(bufoff, gbase, voff) do { _Pragma("unroll") for (int _i = 0; _i < 2; ++_i) \
        __builtin_amdgcn_global_load_lds((const unsigned*)((const char*)(gbase) + (voff)[_i]), (LAS unsigned*)(lds + (bufoff) + ldsw + _i * 8192), 16, 0, 0); } while (0)
#define PG8_LDA(dst, b, h) do { _Pragma("unroll") for (int m = 0; m < 4; ++m) _Pragma("unroll") for (int k = 0; k < 2; ++k) dst[m][k] = *(const LAS bf16x8*)(lds + PG8_SA(b, h) + aoff + m * 2048 + k * 1024); } while (0)
#define PG8_LDB(dst, b, h) do { _Pragma("unroll") for (int n = 0; n < 2; ++n) _Pragma("unroll") for (int k = 0; k < 2; ++k) dst[n][k] = *(const LAS bf16x8*)(lds + PG8_SB(b, h) + boff + n * 2048 + k * 1024); } while (0)
#define PG8_MMA(ai, bj, At, Bt) do { __builtin_amdgcn_s_setprio(1); _Pragma("unroll") for (int m = 0; m < 4; ++m) _Pragma("unroll") for (int n = 0; n < 2; ++n) _Pragma("unroll") for (int k = 0; k < 2; ++k) \
        acc[ai][bj][m][n] = __builtin_amdgcn_mfma_f32_16x16x32_bf16(Bt[n][k], At[m][k], acc[ai][bj][m][n], 0, 0, 0); __builtin_amdgcn_s_setprio(0); } while (0)
#define PG8_WAIT_V(n) asm volatile("s_waitcnt vmcnt(" #n ")" ::: "memory")
#define PG8_WAIT_L(n) asm volatile("s_waitcnt lgkmcnt(" #n ")" ::: "memory")
#define PG8_BAR __builtin_amdgcn_s_barrier()
#define PG8_SCHED __builtin_amdgcn_sched_barrier(0)
    Unit cur, nxt; int ui = 0;
    if (!S.next(0, cur)) return;
    f32x4 acc[2][2][4][2];
#pragma unroll
    for (int a = 0; a < 2; ++a)
#pragma unroll
        for (int b = 0; b < 2; ++b)
#pragma unroll
            for (int m = 0; m < 4; ++m)
#pragma unroll
                for (int n = 0; n < 2; ++n) acc[a][b][m][n] = (f32x4){0.f, 0.f, 0.f, 0.f};
    bf16x8 At[4][2], B0[2][2], B1[2][2];
    const char* cA = (const char*)g.A + (size_t)rowbase(cur.pm) * rstep; const char* cB = (const char*)g.Bt + (size_t)cur.pn * tstep;
    if (Epi::TAB) {
        const f32x2 rv = E.row_fetch(cur.pm, tid);
        float cv[TAB_MAXU];
#pragma unroll
        for (int i = 0; i < TAB_MAXU; ++i) { Unit uu; cv[i] = S.next(i, uu) ? E.col_fetch(uu.pn, tid) : 0.f; }
        if (tid < 256) *(LAS f32x2*)(lds + TAB_OFF + tid * 8) = rv;
#pragma unroll
        for (int i = 0; i < TAB_MAXU; ++i) *(LAS float*)(lds + TABC_OFF + i * TABC_BYTES + tid * 4) = cv[i];
        asm volatile("s_waitcnt vmcnt(0) lgkmcnt(0)" ::: "memory");
    }
    if constexpr (SP2) {
        PG8_STAGE(PG8_SB(0, 0), cB, voffB); PG8_STAGE(PG8_SB(0, 1), cB + hstep, voffB); PG8_STAGE(PG8_SA(0, 0), cA, voffA); PG8_STAGE(PG8_SA(0, 1), cA + hstep, voffA);
        if (wr == 1) PG8_BAR;
        PG8_WAIT_V(2); PG8_BAR;
        PG8_STAGE(PG8_SB(1, 0), cB + kstep, voffB); PG8_STAGE(PG8_SA(1, 0), cA + kstep, voffA); PG8_STAGE(PG8_SB(1, 1), cB + hstep + kstep, voffB);
        PG8_WAIT_V(6); PG8_BAR;
    } else {
    PG8_STAGE(PG8_SB(0, 0), cB, voffB); PG8_STAGE(PG8_SA(0, 0), cA, voffA); PG8_STAGE(PG8_SB(0, 1), cB + hstep, voffB); PG8_STAGE(PG8_SA(0, 1), cA + hstep, voffA);
    if (wr == 1) PG8_BAR;
    PG8_WAIT_V(4); PG8_BAR;
    PG8_STAGE(PG8_SB(1, 0), cB + kstep, voffB); PG8_STAGE(PG8_SA(1, 0), cA + kstep, voffA); PG8_STAGE(PG8_SB(1, 1), cB + hstep + kstep, voffB);
    PG8_WAIT_V(6); PG8_BAR;
    }
    for (;;) {
        const bool has_next = S.next(ui + 1, nxt);
        const char* nA = has_next ? (const char*)g.A + (size_t)rowbase(nxt.pm) * rstep : cA; const char* nB = has_next ? (const char*)g.Bt + (size_t)nxt.pn * tstep : cB;
        for (int t = 0; t < nt; t += 2) {
            const bool last = (t == nt - 2);
            const char* a1 = cA + (size_t)(t + 1) * kstep;
            const char* a2 = last ? nA : cA + (size_t)(t + 2) * kstep; const char* b2 = last ? nB : cB + (size_t)(t + 2) * kstep;
            const char* a3 = a2 + kstep; const char* b3 = b2 + kstep;
            if constexpr (SP2) {
            PG8_LDB(B0, 0, 0); PG8_LDB(B1, 0, 1); PG8_SCHED; PG8_LDA(At, 0, 0); PG8_STAGE(PG8_SA(1, 1), a1 + hstep, voffA);
            PG8_WAIT_V(8); PG8_WAIT_L(0); PG8_BAR; PG8_MMA(0, 0, At, B0); PG8_MMA(0, 1, At, B1); PG8_BAR; PG8_SCHED;
            PG8_LDA(At, 0, 1); PG8_STAGE(PG8_SB(0, 0), b2, voffB); PG8_STAGE(PG8_SB(0, 1), b2 + hstep, voffB); PG8_STAGE(PG8_SA(0, 0), a2, voffA);
            PG8_WAIT_V(8); PG8_WAIT_L(0); PG8_BAR; PG8_MMA(1, 0, At, B0); PG8_MMA(1, 1, At, B1); PG8_BAR; PG8_SCHED;
            PG8_LDB(B0, 1, 0); PG8_LDB(B1, 1, 1); PG8_SCHED; PG8_LDA(At, 1, 0); PG8_STAGE(PG8_SA(0, 1), a2 + hstep, voffA);
            PG8_WAIT_V(8); PG8_WAIT_L(0); PG8_BAR; PG8_MMA(0, 0, At, B0); PG8_MMA(0, 1, At, B1); PG8_BAR; PG8_SCHED;
            PG8_LDA(At, 1, 1); PG8_STAGE(PG8_SB(1, 0), b3, voffB); PG8_STAGE(PG8_SB(1, 1), b3 + hstep, voffB); PG8_STAGE(PG8_SA(1, 0), a3, voffA);
            PG8_WAIT_V(8); PG8_WAIT_L(0); PG8_BAR; PG8_MMA(1, 0, At, B0); PG8_MMA(1, 1, At, B1); PG8_BAR; PG8_SCHED;
            } else {
            PG8_LDB(B0, 0, 0); PG8_SCHED; PG8_LDA(At, 0, 0); PG8_STAGE(PG8_SA(1, 1), a1 + hstep, voffA);
            PG8_WAIT_L(8); PG8_BAR; PG8_WAIT_L(0); PG8_MMA(0, 0, At, B0); PG8_BAR; PG8_SCHED;
            PG8_LDB(B1, 0, 1); PG8_STAGE(PG8_SB(0, 0), b2, voffB);
            PG8_BAR; PG8_WAIT_L(0); PG8_MMA(0, 1, At, B1); PG8_BAR;
            PG8_LDA(At, 0, 1); PG8_STAGE(PG8_SA(0, 0), a2, voffA);
            PG8_BAR; PG8_WAIT_L(0); PG8_MMA(1, 0, At, B0); PG8_BAR; PG8_SCHED;
            PG8_STAGE(PG8_SB(0, 1), b2 + hstep, voffB);
            PG8_WAIT_V(6); PG8_BAR; PG8_MMA(1, 1, At, B1); PG8_BAR;
            PG8_LDB(B0, 1, 0); PG8_SCHED; PG8_LDA(At, 1, 0); PG8_STAGE(PG8_SA(0, 1), a2 + hstep, voffA);
            PG8_WAIT_L(8); PG8_BAR; PG8_WAIT_L(0); PG8_MMA(0, 0, At, B0); PG8_BAR; PG8_SCHED;
            PG8_LDB(B1, 1, 1); PG8_STAGE(PG8_SB(1, 0), b3, voffB);
            PG8_BAR; PG8_WAIT_L(0); PG8_MMA(0, 1, At, B1); PG8_BAR;
            PG8_LDA(At, 1, 1); PG8_STAGE(PG8_SA(1, 0), a3, voffA);
            PG8_BAR; PG8_WAIT_L(0); PG8_MMA(1, 0, At, B0); PG8_BAR; PG8_SCHED;
            PG8_STAGE(PG8_SB(1, 1), b3 + hstep, voffB);
            PG8_WAIT_V(6); PG8_BAR; PG8_MMA(1, 1, At, B1); PG8_BAR;
            }
        }
        if constexpr (ALIGN_EPI) { if (wr == 0) PG8_BAR; }
        E(acc, cur, wr, wc, fr, fq, lds + TAB_OFF, lds + TABC_OFF + (ui < TAB_MAXU ? ui : TAB_MAXU - 1) * TABC_BYTES);
        if (!has_next) break;
#pragma unroll
        for (int a = 0; a < 2; ++a)
#pragma unroll
            for (int b = 0; b < 2; ++b)
#pragma unroll
                for (int m = 0; m < 4; ++m)
#pragma unroll
                    for (int n = 0; n < 2; ++n) acc[a][b][m][n] = (f32x4){0.f, 0.f, 0.f, 0.f};
        cur = nxt; cA = nA; cB = nB; ++ui;
        if constexpr (ALIGN_EPI) { if (wr == 1) PG8_BAR; }
    }
    PG8_WAIT_V(0);
    if constexpr (!ALIGN_EPI) { if (wr == 0) PG8_BAR; }
    PG8_BAR;
#undef PG8_SA
#undef PG8_SB
#undef PG8_STAGE
#undef PG8_LDA
#undef PG8_LDB
#undef PG8_MMA
#undef PG8_WAIT_V
#undef PG8_WAIT_L
#undef PG8_BAR
#undef PG8_SCHED
}
}

template <int KIND>
DI void skinny_phase(LAS unsigned char* lds, const bf16_t* A, int K, const bf16_t* Wt, int nunits, bf16_t* O16, float* O32, float coef,
                     const float* STin, const float* GW, const float* BW, const float* lg, const float* lb, float* STout, bf16_t* H16o) {
    int tid_ = threadIdx.x; asm volatile("" : "+v"(tid_));
    const int tid = tid_, wid = __builtin_amdgcn_readfirstlane(tid >> 6), lane = tid & 63, fr = lane & 15, fq = lane >> 4;
    LAS float* red = (LAS float*)lds;
    LAS float* red2 = (LAS float*)(lds + 16384);
    const int kper = (K / 32) / 8, ks0 = wid * kper, ks1 = ks0 + kper;
    const bf16x8 zero8 = (bf16x8){0, 0, 0, 0, 0, 0, 0, 0};
    for (int u = blockIdx.x; u < nunits; u += gridDim.x) {
        int r0, r1;
        if (KIND == 0) { const int j0 = 16 * u; r0 = (j0 >> 7) * 256 + (j0 & 127); r1 = r0 + 128; } else { r0 = 32 * u; r1 = r0 + 16; }
        f32x4 acc0 = (f32x4){0.f, 0.f, 0.f, 0.f}, acc1 = (f32x4){0.f, 0.f, 0.f, 0.f};
        const bf16_t* a0 = A + (size_t)fr * K + fq * 8;
        const bf16_t* b0 = Wt + (size_t)(r0 + fr) * K + fq * 8;
        const bf16_t* b1 = Wt + (size_t)(r1 + fr) * K + fq * 8;
        bf16x8 ca[4], cb0[4], cb1[4];
#pragma unroll
        for (int s = 0; s < 4; ++s) { const bool ok = ks0 + s < ks1; const int k = (ks0 + s) * 32; ca[s] = zero8; cb0[s] = zero8; cb1[s] = zero8;
            if (ok) { ca[s] = *(const bf16x8*)(a0 + k); cb0[s] = *(const bf16x8*)(b0 + k); cb1[s] = *(const bf16x8*)(b1 + k); } }
        for (int ks = ks0; ks < ks1; ks += 4) {
            bf16x8 na[4], nb0[4], nb1[4];
#pragma unroll
            for (int s = 0; s < 4; ++s) { const bool ok = ks + 4 + s < ks1; const int k = (ks + 4 + s) * 32; na[s] = zero8; nb0[s] = zero8; nb1[s] = zero8;
                if (ok) { na[s] = *(const bf16x8*)(a0 + k); nb0[s] = *(const bf16x8*)(b0 + k); nb1[s] = *(const bf16x8*)(b1 + k); } }
#pragma unroll
            for (int s = 0; s < 4; ++s) { acc0 = mfma16(ca[s], cb0[s], acc0); acc1 = mfma16(ca[s], cb1[s], acc1); }
#pragma unroll
            for (int s = 0; s < 4; ++s) { ca[s] = na[s]; cb0[s] = nb0[s]; cb1[s] = nb1[s]; }
        }
#pragma unroll
        for (int j = 0; j < 4; ++j) { red[(wid * 16 + 4 * fq + j) * 32 + fr] = acc0[j]; red[(wid * 16 + 4 * fq + j) * 32 + 16 + fr] = acc1[j]; }
        __syncthreads();
        { float s = 0.f;
#pragma unroll
          for (int w = 0; w < 8; ++w) s += red[w * 512 + tid];
          red2[tid] = s; }
        __syncthreads();
        const int r = tid >> 5, c = tid & 31;
        const f32x2 rs_ = row_stats(STin, (size_t)r); const float rstd = rs_.x, mu = rs_.y;
        if (KIND == 0) {
            if (c < 16) { const float rm = rstd * mu;
                const float gv = red2[r * 32 + c] * rstd - rm * GW[r0 + c] + BW[r0 + c], uv = red2[r * 32 + 16 + c] * rstd - rm * GW[r1 + c] + BW[r1 + c];
                const bf16_t o = f2bf(silu_f(gv) * uv);
#pragma unroll
                for (int bb = 0; bb < NBATCH; ++bb) O16[((size_t)bb * LT + r) * FF + 16 * u + c] = o; }
        } else if (KIND == 1) {
            const int col = 32 * u + c;
            float h = O32[(size_t)r * D + col]; if (STin) h = (h - mu) * rstd * lg[col] + lb[col];
            const float xn = h * ALPHA + red2[tid] * coef; const bf16_t xb = f2bf(xn);
            float ps = xn, pq = xn * xn;
#pragma unroll
            for (int o = 1; o < 32; o <<= 1) { ps += shx(ps, o, lane); pq += shx(pq, o, lane); }
#pragma unroll
            for (int bb = 0; bb < NBATCH; ++bb) { const size_t row = (size_t)bb * LT + r; O32[row * D + col] = xn; H16o[row * D + col] = xb;
                if (c == 0) { unsafeAtomicAdd(STout + row * 2, ps); unsafeAtomicAdd(STout + row * 2 + 1, pq); } }
        } else {
            const int col = 32 * u + c; const float v = red2[tid] * rstd - rstd * mu * GW[col] + BW[col]; const bf16_t vb = f2bf(v);
#pragma unroll
            for (int bb = 0; bb < NBATCH; ++bb) { const size_t row = (size_t)bb * LT + r; O16[row * NIN + col] = vb;
                if (col >= C_F && col < C_F + 24) O32[row * 32 + col - C_F] = v; }
        }
        __syncthreads();
    }
}

DI void transpose_item(const float* W, int N, int k0, int sc, bf16_t* dst, int K, LAS float* scr, int lane, const float* gvec = nullptr, const float* bvec = nullptr, float* GWp = nullptr, float* BWp = nullptr) {
    float tv[32];
#pragma unroll
    for (int i = 0; i < 32; ++i) { const int kk = 2 * i + (lane >> 5); tv[i] = sc >= 0 ? W[(size_t)(k0 + kk) * N + sc] : 0.f; }
    if (gvec) {
        const float gl = gvec[k0 + lane], bl = bvec[k0 + lane]; float sg = 0.f, sb = 0.f; const bool hi = lane >= 32;
#pragma unroll
        for (int i = 0; i < 32; ++i) {
            const float g0 = RLF(gl, 2 * i), g1 = RLF(gl, 2 * i + 1), b0 = RLF(bl, 2 * i), b1 = RLF(bl, 2 * i + 1);
            sb += tv[i] * (hi ? b1 : b0); tv[i] *= (hi ? g1 : g0); sg += tv[i]; }
        sg += shx(sg, 32, lane); sb += shx(sb, 32, lane);
        if (lane < 32 && sc >= 0) { unsafeAtomicAdd(GWp + lane, sg); unsafeAtomicAdd(BWp + lane, sb); }
    }
#pragma unroll
    for (int i = 0; i < 32; ++i) { const int kk = 2 * i + (lane >> 5); scr[kk * 33 + (lane & 31)] = tv[i]; }
    LDS_WAIT();
    const int c = lane & 7;
#pragma unroll
    for (int j = 0; j < 4; ++j) { const int n = (lane >> 3) + 8 * j; const LAS float* s = scr + (8 * c) * 33 + n;
        u32x4 o; o.x = cvt_pk_bf16(s[0 * 33], s[1 * 33]); o.y = cvt_pk_bf16(s[2 * 33], s[3 * 33]); o.z = cvt_pk_bf16(s[4 * 33], s[5 * 33]); o.w = cvt_pk_bf16(s[6 * 33], s[7 * 33]);
        *(u32x4*)(dst + (size_t)n * K + 8 * c) = o; }
    LDS_WAIT();
}

struct Params { const float* in[25]; float* out; unsigned char* ws; int ph_lo, ph_hi; };

DI void prep_phase(LAS unsigned char* lds, const Params& p) {
    int tid_ = threadIdx.x; asm volatile("" : "+v"(tid_));
    const int tid = tid_, wid = __builtin_amdgcn_readfirstlane(tid >> 6), lane = tid & 63;
    LAS float* scr = (LAS float*)(lds + wid * 8448);
    const int gw = blockIdx.x * 8 + wid, NGW = gridDim.x * 8;
    constexpr int I_GU = 32 * 176, I_DN = 88 * 64, I_IN = 32 * 145, I_OUT = 32 * 64, I_PW = 8;
    constexpr int S0 = 8 * I_GU, S1 = S0 + 4 * I_DN, S2 = S1 + 2 * I_IN, S3 = S2 + 2 * I_OUT, S4 = S3 + 8 * I_PW;
    unsigned char* ws = p.ws;
    for (int it = gw; it < S4; it += NGW) {
        if (it < S0) {
            const int mi = it / I_GU, r = it % I_GU, q = mi >> 1, part = mi & 1, l = q >> 1, f = q & 1;
            const float* W = p.in[(f ? 20 : 2) + part] + (size_t)l * D * FF;
            const int kb = r / 176, nb = r % 176, n0 = 32 * nb;
            bf16_t* WT = (bf16_t*)(ws + WS_WGU + (size_t)q * SZ_WGU);
            const int drow = (n0 >> 7) * 256 + (n0 & 127) + part * 128;
            const float* gvec = f ? p.in[18] + l * D : (l ? p.in[23] + (l - 1) * D : nullptr);
            const float* bvec = f ? p.in[19] + l * D : (l ? p.in[24] + (l - 1) * D : nullptr);
            transpose_item(W, FF, 64 * kb, n0 + (lane & 31), WT + (size_t)drow * D + 64 * kb, D, scr, lane, gvec, bvec,
                           (float*)(ws + WS_GWGU) + (size_t)q * 2 * FF + drow, (float*)(ws + WS_BWGU) + (size_t)q * 2 * FF + drow);
        } else if (it < S1) {
            const int j = it - S0, q = j / I_DN, r = j % I_DN, l = q >> 1, f = q & 1;
            const float* W = p.in[f ? 22 : 4] + (size_t)l * FF * D;
            const int kb = r / 64, nb = r % 64;
            bf16_t* WT = (bf16_t*)(ws + WS_WDN + (size_t)q * SZ_WDN);
            transpose_item(W, D, 64 * kb, 32 * nb + (lane & 31), WT + (size_t)(32 * nb) * FF + 64 * kb, FF, scr, lane);
        } else if (it < S2) {
            const int j = it - S1, l = j / I_IN, r = j % I_IN;
            const float* W = p.in[7] + (size_t)l * D * 4632;
            const int kb = r / 145, nb = r % 145, dn = 32 * nb + (lane & 31);
            int sc;
            if (dn < 1536) sc = dn; else if (dn < 4608) sc = dn + 8; else if (dn < 4616) sc = 1536 + (dn - 4608); else if (dn < 4632) sc = dn; else sc = -1;
            bf16_t* WT = (bf16_t*)(ws + WS_WIN + (size_t)l * SZ_WIN);
            transpose_item(W, 4632, 64 * kb, sc, WT + (size_t)(32 * nb) * D + 64 * kb, D, scr, lane, p.in[5] + l * D, p.in[6] + l * D,
                           (float*)(ws + WS_GWIN) + (size_t)l * NIN + 32 * nb, (float*)(ws + WS_BWIN) + (size_t)l * NIN + 32 * nb);
        } else if (it < S3) {
            const int j = it - S2, l = j / I_OUT, r = j % I_OUT;
            const float* W = p.in[17] + (size_t)l * D * D;
            const int kb = r / 64, nb = r % 64;
            bf16_t* WT = (bf16_t*)(ws + WS_WOUT + (size_t)l * SZ_WOUT);
            transpose_item(W, D, 64 * kb, 32 * nb + (lane & 31), WT + (size_t)(32 * nb) * D + 64 * kb, D, scr, lane);
        } else {
            const int j = it - S3, lg = j / I_PW, r = j % I_PW;
            const float* W = p.in[9] + (size_t)lg * 128 * 128;
            const int kb = r / 4, nb = r % 4;
            bf16_t* WT = (bf16_t*)(ws + WS_PWT) + (size_t)lg * 128 * 128;
            transpose_item(W, 128, 64 * kb, 32 * nb + (lane & 31), WT + (size_t)(32 * nb) * 128 + 64 * kb, 128, scr, lane);
        }
    }
    float* H32 = (float*)(ws + WS_H32); bf16_t* H16 = (bf16_t*)(ws + WS_H16);
    for (int row = gw; row < R; row += NGW) {
        const int b = row / LT, t = row % LT;
        const float* src = t < NMETA ? p.in[1] + (size_t)t * D : p.in[0] + ((size_t)b * SEQ + (t - NMETA)) * D;
#pragma unroll
        for (int j = 0; j < 8; ++j) { const int col = 4 * lane + 256 * j; const f32x4 v = *(const f32x4*)(src + col);
            *(f32x4*)(H32 + (size_t)row * D + col) = v; u32x2 w; w.x = cvt_pk_bf16(v[0], v[1]); w.y = cvt_pk_bf16(v[2], v[3]); *(u32x2*)(H16 + (size_t)row * D + col) = w; }
    }
}

DI void ln_phase(float* H32, bf16_t* H16, const float* g, const float* bta, float* out) {
    int tid_ = threadIdx.x; asm volatile("" : "+v"(tid_));
    const int tid = tid_, wid = __builtin_amdgcn_readfirstlane(tid >> 6), lane = tid & 63;
    const int gw = blockIdx.x * 8 + wid, NGW = gridDim.x * 8;
    f32x4 gv[8], bv[8];
#pragma unroll
    for (int j = 0; j < 8; ++j) { gv[j] = *(const f32x4*)(g + 4 * lane + 256 * j); bv[j] = *(const f32x4*)(bta + 4 * lane + 256 * j); }
    for (int row = gw; row < R; row += NGW) {
        float* hr = H32 + (size_t)row * D;
        f32x4 v[8]; float s = 0.f;
#pragma unroll
        for (int j = 0; j < 8; ++j) { v[j] = *(const f32x4*)(hr + 4 * lane + 256 * j); s += (v[j][0] + v[j][1]) + (v[j][2] + v[j][3]); }
        const float mean = wave_sum(s, lane) * (1.f / D); float s2 = 0.f;
#pragma unroll
        for (int j = 0; j < 8; ++j) { v[j] = v[j] - mean; s2 += (v[j][0] * v[j][0] + v[j][1] * v[j][1]) + (v[j][2] * v[j][2] + v[j][3] * v[j][3]); }
        const float rstd = __builtin_amdgcn_rsqf(wave_sum(s2, lane) * (1.f / D) + LN_EPS);
        if (out) {
            const int b = row / LT, t = row % LT;
            if (t >= NMETA) { float* orow = out + ((size_t)b * SEQ + (t - NMETA)) * D;
#pragma unroll
                for (int j = 0; j < 8; ++j) *(f32x4*)(orow + 4 * lane + 256 * j) = v[j] * rstd * gv[j] + bv[j]; }
        } else {
            bf16_t* br = H16 + (size_t)row * D;
#pragma unroll
            for (int j = 0; j < 8; ++j) { const f32x4 y = v[j] * rstd * gv[j] + bv[j]; *(f32x4*)(hr + 4 * lane + 256 * j) = y;
                u32x2 w; w.x = cvt_pk_bf16(y[0], y[1]); w.y = cvt_pk_bf16(y[2], y[3]); *(u32x2*)(br + 4 * lane + 256 * j) = w; }
        }
    }
}

DI void conv16(const bf16_t* P, int b, int t, int ch0, const float* cw, const float* cb, float (&o)[16]) {
    if (t < 0) {
#pragma unroll
        for (int e = 0; e < 16; ++e) o[e] = 0.f;
        return;
    }
#pragma unroll
    for (int q = 0; q < 4; ++q) { const f32x4 bq = *(const f32x4*)(cb + ch0 + 4 * q); o[4 * q] = bq[0]; o[4 * q + 1] = bq[1]; o[4 * q + 2] = bq[2]; o[4 * q + 3] = bq[3]; }
#pragma unroll
    for (int j = 0; j < 4; ++j) {
        const int tt = t - 3 + j;
        if (tt >= 0) {
            const bf16_t* xp = P + ((size_t)b * LT + tt) * NIN + C_X + ch0;
            const u32x4 x0 = *(const u32x4*)xp, x1 = *(const u32x4*)(xp + 8);
            float wp[16];
#pragma unroll
            for (int q = 0; q < 4; ++q) { const f32x4 wq = *(const f32x4*)(cw + j * 1536 + ch0 + 4 * q); wp[4 * q] = wq[0]; wp[4 * q + 1] = wq[1]; wp[4 * q + 2] = wq[2]; wp[4 * q + 3] = wq[3]; }
#pragma unroll
            for (int q = 0; q < 4; ++q) {
                o[2 * q] += wp[2 * q] * __uint_as_float(x0[q] << 16); o[2 * q + 1] += wp[2 * q + 1] * __uint_as_float(x0[q] & 0xffff0000u);
                o[8 + 2 * q] += wp[8 + 2 * q] * __uint_as_float(x1[q] << 16); o[8 + 2 * q + 1] += wp[8 + 2 * q + 1] * __uint_as_float(x1[q] & 0xffff0000u);
            }
        }
    }
#pragma unroll
    for (int e = 0; e < 16; ++e) o[e] = silu_f(o[e]);
}

DI void cumsum_item(LAS unsigned char* lds, const float* FDT, const float* bfg, float* CC, int bh) {
    int tid_ = threadIdx.x; asm volatile("" : "+v"(tid_));
    const int tid = tid_, wid = __builtin_amdgcn_readfirstlane(tid >> 6), lane = tid & 63;
    LAS float* wsum = (LAS float*)lds;
    const int b = bh >> 3, h = bh & 7; const float bias = bfg[h];
    float xv[9];
#pragma unroll
    for (int j = 0; j < 9; ++j) { const int t = tid * 9 + j; xv[j] = t < LT ? FDT[((size_t)b * LT + t) * 32 + h] + bias : 0.f; }
    float s = 0.f;
#pragma unroll
    for (int j = 0; j < 9; ++j) { const int t = tid * 9 + j; const float x = xv[j]; s += t < LT ? fminf(x, 0.f) - __logf(1.f + __expf(-fabsf(x))) : 0.f; xv[j] = s; }
    const float incl = wave_incl_scan(s, lane);
    __syncthreads();
    if (lane == 63) wsum[wid] = incl;
    __syncthreads();
    float off = incl - s;
    for (int w = 0; w < wid; ++w) off += wsum[w];
#pragma unroll
    for (int j = 0; j < 9; ++j) { const int t = tid * 9 + j; if (t < LT) CC[(size_t)bh * LT + t] = off + xv[j]; }
}

DI void chunk_dt(const float* FDT, const float* dt_bias, const float* a_log, int b, int t0, int h, int lane, float& dt0, float& dt1, float& ac0, float& ac1, float& total) {
    const int ta = t0 + 2 * lane, tb = ta + 1;
    const float bias = dt_bias[h], a = -__expf(a_log[h]);
    dt0 = ta >= 0 ? softplus_f(FDT[((size_t)b * LT + ta) * 32 + 8 + h] + bias) : 0.f;
    dt1 = tb >= 0 ? softplus_f(FDT[((size_t)b * LT + tb) * 32 + 8 + h] + bias) : 0.f;
    const float x0 = dt0 * a, x1 = dt1 * a, s = x0 + x1;
    const float incl = wave_incl_scan(s, lane), excl = incl - s;
    ac0 = excl + x0; ac1 = excl + s; total = __uint_as_float(__builtin_amdgcn_readlane(__float_as_uint(incl), 63));
}

DI void ssda_item(int it, LAS unsigned char* lds, const bf16_t* P, const float* FDT, const float* cw, const float* cb, const float* dt_bias, const float* a_log, float* ST, float* CD) {
    int tid_ = threadIdx.x; asm volatile("" : "+v"(tid_));
    const int tid = tid_, wid = __builtin_amdgcn_readfirstlane(tid >> 6), lane = tid & 63, fr = lane & 15, fq = lane >> 4;
    LAS bf16_t* xsT = (LAS bf16_t*)lds;
    LAS bf16_t* BmT = (LAS bf16_t*)(lds + 34816);
    LAS float* wl = (LAS float*)(lds + 69632);
    const int g = it & 1, rest = it >> 1, c = rest % NBLK, b = rest / NBLK, t0 = 128 * c - 112;
    { float dt0, dt1, ac0, ac1, total; chunk_dt(FDT, dt_bias, a_log, b, t0, g * 8 + wid, lane, dt0, dt1, ac0, ac1, total);
      wl[wid * 128 + 2 * lane] = dt0 * __expf(total - ac0); wl[wid * 128 + 2 * lane + 1] = dt1 * __expf(total - ac1);
      if (lane == 63) CD[(b * NBLK + c) * 16 + g * 8 + wid] = __expf(total); }
#pragma unroll
    for (int i = 0; i < 2; ++i) { const int l = (wid & 1) * 64 + lane, cg8 = (wid >> 1) + 4 * i; float o[16]; conv16(P, b, t0 + l, 1024 + g * 128 + cg8 * 16, cw, cb, o);
#pragma unroll
      for (int e = 0; e < 16; ++e) BmT[(cg8 * 16 + e) * 136 + l] = f2bf(o[e]); }
    __syncthreads();
    bf16x8 af[4];
#pragma unroll
    for (int ks = 0; ks < 4; ++ks) af[ks] = *(const LAS bf16x8*)(BmT + (16 * wid + fr) * 136 + ks * 32 + fq * 8);
    for (int h8 = 0; h8 < 8; ++h8) {
        const int h = g * 8 + h8;
        LAS bf16_t* xb = xsT + (h8 & 1) * (64 * 136);
        { const int l = (wid & 1) * 64 + lane, cg4 = wid >> 1; float o[16]; conv16(P, b, t0 + l, h * 64 + cg4 * 16, cw, cb, o); const float w = wl[h8 * 128 + l];
#pragma unroll
          for (int e = 0; e < 16; ++e) xb[(cg4 * 16 + e) * 136 + l] = f2bf(o[e] * w); }
        __syncthreads();
        float* stp = ST + ((size_t)((b * NBLK + c) * 16 + h)) * 8192;
#pragma unroll
        for (int mt = 0; mt < 4; ++mt) { f32x4 acc = (f32x4){0.f, 0.f, 0.f, 0.f};
#pragma unroll
            for (int ks = 0; ks < 4; ++ks) { const bf16x8 xf = *(const LAS bf16x8*)(xb + (16 * mt + fr) * 136 + ks * 32 + fq * 8); acc = mfma16(af[ks], xf, acc); }
            *(f32x4*)(stp + (16 * mt + fr) * 128 + 16 * wid + 4 * fq) = acc; }
    }
}

DI void scan_phase(float* ST, const float* CD) {
    int tid_ = threadIdx.x; asm volatile("" : "+v"(tid_));
    for (int e4 = blockIdx.x * NTHR + tid_; e4 < NBATCH * 16 * 64 * 32; e4 += gridDim.x * NTHR) {
        const int n4 = e4 & 31, pp = (e4 >> 5) & 63, h = (e4 >> 11) & 15, b = e4 >> 15;
        f32x4 hs = (f32x4){0.f, 0.f, 0.f, 0.f};
#pragma unroll 11
        for (int c = 0; c < NBLK; ++c) { f32x4* ptr = (f32x4*)(ST + ((size_t)((b * NBLK + c) * 16 + h)) * 8192 + pp * 128 + n4 * 4); const f32x4 s = *ptr; *ptr = hs; const float d = CD[(b * NBLK + c) * 16 + h]; hs = hs * d + s; }
    }
}

DI void ssdc_item(int it, LAS unsigned char* lds, const bf16_t* P, const float* FDT, const float* cw, const float* cb, const float* dt_bias, const float* a_log, const float* d_skip,
                   const float* norm_w, const float* ST, bf16_t* Y) {
    int tid_ = threadIdx.x; asm volatile("" : "+v"(tid_));
    const int tid = tid_, wid = __builtin_amdgcn_readfirstlane(tid >> 6), lane = tid & 63, fr = lane & 15, fq = lane >> 4;
    LAS bf16_t* BmS = (LAS bf16_t*)lds;
    LAS bf16_t* CmS = (LAS bf16_t*)(lds + 34816);
    LAS bf16_t* xsT = (LAS bf16_t*)(lds + 69632);
    LAS bf16_t* prevS = (LAS bf16_t*)(lds + 87040);
    LAS float* dts = (LAS float*)(lds + 104448);
    LAS float* acss = (LAS float*)(lds + 108544);
    {
        const int g = it & 1, rest = it >> 1, c = rest % NBLK, b = rest / NBLK, t0 = 128 * c - 112;
        { float dt0, dt1, ac0, ac1, total; chunk_dt(FDT, dt_bias, a_log, b, t0, g * 8 + wid, lane, dt0, dt1, ac0, ac1, total);
          dts[wid * 128 + 2 * lane] = dt0; dts[wid * 128 + 2 * lane + 1] = dt1; acss[wid * 128 + 2 * lane] = ac0; acss[wid * 128 + 2 * lane + 1] = ac1; }
#pragma unroll
        for (int i = 0; i < 4; ++i) { const int l = (wid & 1) * 64 + lane, cgi = (wid >> 1) + 4 * i; float o[16];
            conv16(P, b, t0 + l, (cgi < 8 ? 1024 : 1280) + g * 128 + (cgi & 7) * 16, cw, cb, o);
            LAS bf16_t* dst = (cgi < 8 ? BmS : CmS) + l * 136 + (cgi & 7) * 16;
            u32x4 w0, w1; w0.x = cvt_pk_bf16(o[0], o[1]); w0.y = cvt_pk_bf16(o[2], o[3]); w0.z = cvt_pk_bf16(o[4], o[5]); w0.w = cvt_pk_bf16(o[6], o[7]);
            w1.x = cvt_pk_bf16(o[8], o[9]); w1.y = cvt_pk_bf16(o[10], o[11]); w1.z = cvt_pk_bf16(o[12], o[13]); w1.w = cvt_pk_bf16(o[14], o[15]);
            *(LAS u32x4*)dst = w0; *(LAS u32x4*)(dst + 8) = w1; }
        __syncthreads();
        bf16x8 cmf[4];
#pragma unroll
        for (int ks = 0; ks < 4; ++ks) cmf[ks] = *(const LAS bf16x8*)(CmS + (16 * wid + fr) * 136 + ks * 32 + fq * 8);
        f32x4 cbt[8];
#pragma unroll
        for (int nt = 0; nt < 8; ++nt) { cbt[nt] = (f32x4){0.f, 0.f, 0.f, 0.f};
            if (nt <= wid) {
#pragma unroll
                for (int ks = 0; ks < 4; ++ks) { const bf16x8 bmf = *(const LAS bf16x8*)(BmS + (16 * nt + fr) * 136 + ks * 32 + fq * 8); cbt[nt] = mfma16(bmf, cmf[ks], cbt[nt]); } } }
        const int li = 16 * wid + fr, t = t0 + li; const bool valid = t >= 0;
        const size_t grow = (size_t)b * LT + (valid ? t : 0);
        float ssq = 0.f;
        for (int h8 = 0; h8 < 8; ++h8) {
            const int h = g * 8 + h8;
            __syncthreads();
            { const int l = (wid & 1) * 64 + lane, cg4 = wid >> 1; float o[16]; conv16(P, b, t0 + l, h * 64 + cg4 * 16, cw, cb, o);
#pragma unroll
              for (int e = 0; e < 16; ++e) xsT[(cg4 * 16 + e) * 136 + l] = f2bf(o[e]); }
            { const float* stp = ST + ((size_t)((b * NBLK + c) * 16 + h)) * 8192;
#pragma unroll
              for (int i = 0; i < 4; ++i) { const int idx = tid + NTHR * i, pp = idx >> 5, n4 = idx & 31; const f32x4 v = *(const f32x4*)(stp + pp * 128 + n4 * 4);
                  u32x2 w; w.x = cvt_pk_bf16(v[0], v[1]); w.y = cvt_pk_bf16(v[2], v[3]); *(LAS u32x2*)(prevS + pp * 136 + n4 * 4) = w; } }
            u32x2 zw4[4];
#pragma unroll
            for (int pt = 0; pt < 4; ++pt) zw4[pt] = *(const u32x2*)(P + grow * NIN + C_Z + h * 64 + 16 * pt + 4 * fq);
            __syncthreads();
            const float acl = acss[h8 * 128 + li];
            f32x4 yacc[4], yoff[4];
#pragma unroll
            for (int pt = 0; pt < 4; ++pt) { yacc[pt] = (f32x4){0.f, 0.f, 0.f, 0.f}; yoff[pt] = (f32x4){0.f, 0.f, 0.f, 0.f}; }
#pragma unroll
            for (int ksp = 0; ksp < 4; ++ksp) {
                if (2 * ksp <= wid) {
                    const int s0 = 32 * ksp + 4 * fq, s1 = s0 + 16;
                    const f32x4 as0 = *(const LAS f32x4*)(acss + h8 * 128 + s0), as1 = *(const LAS f32x4*)(acss + h8 * 128 + s1);
                    const f32x4 d0 = *(const LAS f32x4*)(dts + h8 * 128 + s0), d1 = *(const LAS f32x4*)(dts + h8 * 128 + s1);
                    float g0[4], g1[4];
#pragma unroll
                    for (int j = 0; j < 4; ++j) {
                        g0[j] = (s0 + j <= li) ? cbt[2 * ksp][j] * __expf(acl - as0[j]) * d0[j] : 0.f;
                        g1[j] = (s1 + j <= li) ? cbt[2 * ksp + 1][j] * __expf(acl - as1[j]) * d1[j] : 0.f;
                    }
                    u32x4 gw; gw.x = cvt_pk_bf16(g0[0], g0[1]); gw.y = cvt_pk_bf16(g0[2], g0[3]); gw.z = cvt_pk_bf16(g1[0], g1[1]); gw.w = cvt_pk_bf16(g1[2], g1[3]);
                    const bf16x8 gf = __builtin_bit_cast(bf16x8, gw);
#pragma unroll
                    for (int pt = 0; pt < 4; ++pt) {
                        const s16x4 lo = *(const LAS s16x4*)(xsT + (16 * pt + fr) * 136 + s0), hi = *(const LAS s16x4*)(xsT + (16 * pt + fr) * 136 + s1);
                        const bf16x8 xf = __builtin_shufflevector(lo, hi, 0, 1, 2, 3, 4, 5, 6, 7);
                        yacc[pt] = mfma16(xf, gf, yacc[pt]);
                    }
                }
            }
#pragma unroll
            for (int ks = 0; ks < 4; ++ks)
#pragma unroll
                for (int pt = 0; pt < 4; ++pt) { const bf16x8 pf = *(const LAS bf16x8*)(prevS + (16 * pt + fr) * 136 + ks * 32 + fq * 8); yoff[pt] = mfma16(pf, cmf[ks], yoff[pt]); }
            const float eal = __expf(acl), dsk = d_skip[h];
#pragma unroll
            for (int pt = 0; pt < 4; ++pt) {
                const int p0 = 16 * pt + 4 * fq;
                const u32x2 zw = zw4[pt];
                float zz[4] = {__uint_as_float(zw.x << 16), __uint_as_float(zw.x & 0xffff0000u), __uint_as_float(zw.y << 16), __uint_as_float(zw.y & 0xffff0000u)};
                float gy[4];
#pragma unroll
                for (int j = 0; j < 4; ++j) { const float xv = bf2f(xsT[(p0 + j) * 136 + li]); const float y = yacc[pt][j] + eal * yoff[pt][j] + xv * dsk; gy[j] = y * silu_f(zz[j]); ssq += gy[j] * gy[j]; }
                if (valid) { u32x2 w; w.x = cvt_pk_bf16(gy[0], gy[1]); w.y = cvt_pk_bf16(gy[2], gy[3]); *(u32x2*)(Y + grow * D + 1024 + h * 64 + p0) = w; }
            }
        }
        ssq += shx(ssq, 16, lane); ssq += shx(ssq, 32, lane);
        const float rstd = __builtin_amdgcn_rsqf(ssq * (1.f / 512.f) + RMS_EPS);
        if (valid) {
            u32x2 yv[8][4];
#pragma unroll
            for (int h8 = 0; h8 < 8; ++h8)
#pragma unroll
                for (int pt = 0; pt < 4; ++pt) yv[h8][pt] = *(const u32x2*)(Y + grow * D + 1024 + (g * 8 + h8) * 64 + 16 * pt + 4 * fq);
#pragma unroll
            for (int h8 = 0; h8 < 8; ++h8)
#pragma unroll
                for (int pt = 0; pt < 4; ++pt) { const int ch = (g * 8 + h8) * 64 + 16 * pt + 4 * fq; const u32x2 w = yv[h8][pt]; const f32x4 nw = *(const f32x4*)(norm_w + ch);
                    u32x2 o; o.x = cvt_pk_bf16(__uint_as_float(w.x << 16) * rstd * nw[0], __uint_as_float(w.x & 0xffff0000u) * rstd * nw[1]);
                    o.y = cvt_pk_bf16(__uint_as_float(w.y << 16) * rstd * nw[2], __uint_as_float(w.y & 0xffff0000u) * rstd * nw[3]); *(u32x2*)(Y + grow * D + 1024 + ch) = o; }
        }
    }
}

DI void pool_item(int it, LAS unsigned char* lds, const bf16_t* P, const bf16_t* PWT, const float* pscale, bf16_t* Y) {
    int tid_ = threadIdx.x; asm volatile("" : "+v"(tid_));
    const int tid = tid_, wid = __builtin_amdgcn_readfirstlane(tid >> 6), lane = tid & 63, fr = lane & 15, fq = lane >> 4;
    LAS bf16_t* Us = (LAS bf16_t*)lds;
    LAS bf16_t* Xs = (LAS bf16_t*)(lds + 36608);
    LAS bf16_t* Ws = (LAS bf16_t*)(lds + 36608 + 34816);
    {
        const int g = it & 3, rest = it >> 2, blk = rest % NBLK, b = rest / NBLK, t0 = 128 * blk - 112;
        for (int cidx = tid; cidx < 143 * 16; cidx += NTHR) { const int j = cidx >> 4, ch = cidx & 15, t = t0 - 15 + j;
            u32x4 v = (u32x4){0u, 0u, 0u, 0u}; if (t >= 0) v = *(const u32x4*)(P + ((size_t)b * LT + t) * NIN + C_U + g * 128 + ch * 8);
            *(LAS u32x4*)(Us + j * 128 + ch * 8) = v; }
        for (int cidx = tid; cidx < 128 * 16; cidx += NTHR) { const int d = cidx >> 4, ch = cidx & 15; *(LAS u32x4*)(Ws + d * 136 + ch * 8) = *(const u32x4*)(PWT + (size_t)(g * 128 + d) * 128 + ch * 8); }
        __syncthreads();
        { const int cch = tid & 127, w = 2 << g, i0 = (tid >> 7) * 32;
          float s = 0.f;
          for (int j = 1; j < w; ++j) s += bf2f(Us[(i0 + 15 - j) * 128 + cch]);
          for (int k = 0; k < 32; ++k) { const int i = i0 + k, t = t0 + i;
              const float ucur = bf2f(Us[(i + 15) * 128 + cch]); s += ucur;
              const int cnt = t + 1 < w ? (t + 1 < 1 ? 1 : t + 1) : w;
              Xs[i * 136 + cch] = f2bf(s / (float)cnt - ucur);
              s -= bf2f(Us[(i + 15 - (w - 1)) * 128 + cch]); } }
        __syncthreads();
        bf16x8 xf[4];
#pragma unroll
        for (int ks = 0; ks < 4; ++ks) xf[ks] = *(const LAS bf16x8*)(Xs + (16 * wid + fr) * 136 + ks * 32 + fq * 8);
        const int t = t0 + 16 * wid + fr;
#pragma unroll
        for (int nt = 0; nt < 8; ++nt) { f32x4 acc = (f32x4){0.f, 0.f, 0.f, 0.f};
#pragma unroll
            for (int ks = 0; ks < 4; ++ks) { const bf16x8 wf = *(const LAS bf16x8*)(Ws + (16 * nt + fr) * 136 + ks * 32 + fq * 8); acc = mfma16(wf, xf[ks], acc); }
            if (t >= 0) { const int d0 = 16 * nt + 4 * fq; const f32x4 sc = *(const f32x4*)(pscale + g * 128 + d0);
                u32x2 w; w.x = cvt_pk_bf16(acc[0] * sc[0], acc[1] * sc[1]); w.y = cvt_pk_bf16(acc[2] * sc[2], acc[3] * sc[3]);
                *(u32x2*)(Y + ((size_t)b * LT + t) * D + 512 + g * 128 + d0) = w; } }
    }
}

DI void attn_item(int it, LAS unsigned char* lds, const bf16_t* P, const float* CC, bf16_t* Y) {
    int tid_ = threadIdx.x; asm volatile("" : "+v"(tid_));
    const int tid = tid_, wid = __builtin_amdgcn_readfirstlane(tid >> 6), lane = tid & 63, fr = lane & 15, fq = lane >> 4;
    LAS bf16_t* Ks = (LAS bf16_t*)lds;
    LAS bf16_t* Vt = (LAS bf16_t*)(lds + 18432);
    LAS float* cks = (LAS float*)(lds + 18432 + 17408);
    {
        const int jp = 16 - (it >> 5), bh = it & 31;
        const int b = bh >> 3, h = bh & 7;
        const size_t rowb = (size_t)b * LT;
        const int qi = 16 * wid + fr;
        int qbs[2]; qbs[0] = 2 * jp; qbs[1] = 2 * jp + 1 <= 32 ? 2 * jp + 1 : -1;
        const int ktmax = qbs[1] >= 0 ? qbs[1] : qbs[0];
        bf16x8 qf[2][2]; float cq[2]; bool qvalid[2]; size_t qrow[2];
        f32x4 oacc[2][4]; float mrun[2], lsum[2];
#pragma unroll
        for (int qq = 0; qq < 2; ++qq) {
            const int tq = 128 * qbs[qq] - 112 + qi; qvalid[qq] = (qbs[qq] >= 0) && (tq >= 0);
            qrow[qq] = rowb + (qvalid[qq] ? tq : 0);
            const bf16_t* qp = P + qrow[qq] * NIN + C_Q + h * 64 + fq * 8;
#pragma unroll
            for (int ks = 0; ks < 2; ++ks) { const u32x4 qw = *(const u32x4*)(qp + 32 * ks); u32x4 qs;
#pragma unroll
                for (int e = 0; e < 4; ++e) qs[e] = cvt_pk_bf16(__uint_as_float(qw[e] << 16) * 0.125f, __uint_as_float(qw[e] & 0xffff0000u) * 0.125f);
                qf[qq][ks] = __builtin_bit_cast(bf16x8, qs); }
            cq[qq] = CC[(size_t)bh * LT + (qvalid[qq] ? tq : 0)];
#pragma unroll
            for (int mt = 0; mt < 4; ++mt) oacc[qq][mt] = (f32x4){0.f, 0.f, 0.f, 0.f};
            mrun[qq] = -1e30f; lsum[qq] = 0.f;
        }
        u32x4 kreg[2], vreg[2]; float creg = 0.f;
#define ATT_PREFETCH(kt_) do { const int tb_ = 128 * (kt_) - 112; \
        _Pragma("unroll") for (int i_ = 0; i_ < 2; ++i_) { const int c_ = tid + NTHR * i_; \
            { const int key_ = c_ >> 3, dch_ = c_ & 7, t_ = tb_ + key_; kreg[i_] = (u32x4){0u, 0u, 0u, 0u}; if (t_ >= 0) kreg[i_] = *(const u32x4*)(P + (rowb + t_) * NIN + C_K + h * 64 + dch_ * 8); } \
            { const int key_ = c_ >> 3, dch_ = c_ & 7, t_ = tb_ + key_; vreg[i_] = (u32x4){0u, 0u, 0u, 0u}; if (t_ >= 0) vreg[i_] = *(const u32x4*)(P + (rowb + t_) * NIN + C_V + h * 64 + dch_ * 8); } } \
        if (tid < 128) { const int t_ = tb_ + tid; creg = t_ >= 0 ? CC[(size_t)bh * LT + t_] : 0.f; } } while (0)
        ATT_PREFETCH(0);
        for (int kt = 0; kt <= ktmax; ++kt) {
            __syncthreads();
#pragma unroll
            for (int i = 0; i < 2; ++i) { const int cidx = tid + NTHR * i;
                { const int key = cidx >> 3, dch = cidx & 7; *(LAS u32x4*)(Ks + key * 72 + dch * 8) = kreg[i]; }
                { const int key = cidx >> 3, dch = cidx & 7, kx = key ^ (4 * dch);
#pragma unroll
                  for (int q = 0; q < 4; ++q) { Vt[(dch * 8 + 2 * q) * 136 + kx] = (bf16_t)(vreg[i][q] & 0xffffu); Vt[(dch * 8 + 2 * q + 1) * 136 + kx] = (bf16_t)(vreg[i][q] >> 16); } } }
            if (tid < 128) cks[tid] = creg;
            __syncthreads();
            if (kt < ktmax) ATT_PREFETCH(kt + 1);
            const bool act0 = kt <= qbs[0], act1 = kt <= qbs[1];
            f32x4 sc[2][8];
#pragma unroll
            for (int nt = 0; nt < 8; ++nt) { const f32x4 ck = *(const LAS f32x4*)(cks + 16 * nt + 4 * fq);
                const bf16x8 kf0 = *(const LAS bf16x8*)(Ks + (16 * nt + fr) * 72 + fq * 8), kf1 = *(const LAS bf16x8*)(Ks + (16 * nt + fr) * 72 + 32 + fq * 8);
                if (act0) { f32x4 s = cq[0] - ck; s = mfma16(kf0, qf[0][0], s); s = mfma16(kf1, qf[0][1], s); sc[0][nt] = s; }
                if (act1) { f32x4 s = cq[1] - ck; s = mfma16(kf0, qf[1][0], s); s = mfma16(kf1, qf[1][1], s); sc[1][nt] = s; } }
            bf16x8 pf[2][4];
#pragma unroll
            for (int qq = 0; qq < 2; ++qq) {
                if (qq == 0 ? act0 : act1) {
                    const int qb = qbs[qq];
                    if (kt == 0 || kt == qb) {
#pragma unroll
                        for (int nt = 0; nt < 8; ++nt)
#pragma unroll
                            for (int j = 0; j < 4; ++j) { const int sl = 16 * nt + 4 * fq + j; const bool ok = (kt > 0 || sl >= 112) && (kt < qb || sl <= qi); sc[qq][nt][j] = ok ? sc[qq][nt][j] : -1e30f; }
                    }
                    float mloc = -1e30f;
#pragma unroll
                    for (int nt = 0; nt < 8; ++nt) mloc = fmaxf(mloc, fmaxf(fmaxf(sc[qq][nt][0], sc[qq][nt][1]), fmaxf(sc[qq][nt][2], sc[qq][nt][3])));
                    mloc = fmaxf(mloc, shx(mloc, 16, lane)); mloc = fmaxf(mloc, shx(mloc, 32, lane));
                    const float mnew = fmaxf(mrun[qq], mloc), alpha = __builtin_amdgcn_exp2f((mrun[qq] - mnew) * LOG2E), mneg = -mnew * LOG2E; mrun[qq] = mnew;
                    float psum = 0.f;
#pragma unroll
                    for (int nt = 0; nt < 8; ++nt)
#pragma unroll
                        for (int j = 0; j < 4; ++j) { const float pv = __builtin_amdgcn_exp2f(__builtin_fmaf(sc[qq][nt][j], LOG2E, mneg)); sc[qq][nt][j] = pv; psum += pv; }
                    lsum[qq] = lsum[qq] * alpha + psum;
#pragma unroll
                    for (int mt = 0; mt < 4; ++mt) oacc[qq][mt] = oacc[qq][mt] * alpha;
#pragma unroll
                    for (int s4 = 0; s4 < 4; ++s4) {
                        u32x4 pw; pw.x = cvt_pk_bf16(sc[qq][2 * s4][0], sc[qq][2 * s4][1]); pw.y = cvt_pk_bf16(sc[qq][2 * s4][2], sc[qq][2 * s4][3]); pw.z = cvt_pk_bf16(sc[qq][2 * s4 + 1][0], sc[qq][2 * s4 + 1][1]); pw.w = cvt_pk_bf16(sc[qq][2 * s4 + 1][2], sc[qq][2 * s4 + 1][3]);
                        pf[qq][s4] = __builtin_bit_cast(bf16x8, pw); }
                }
            }
#pragma unroll
            for (int s4 = 0; s4 < 4; ++s4)
#pragma unroll
                for (int mt = 0; mt < 4; ++mt) {
                    const int vsw = 4 * (2 * mt + (fr >> 3));
                    const s16x4 lo = *(const LAS s16x4*)(Vt + (16 * mt + fr) * 136 + ((32 * s4 + 4 * fq) ^ vsw)), hi = *(const LAS s16x4*)(Vt + (16 * mt + fr) * 136 + ((32 * s4 + 16 + 4 * fq) ^ vsw));
                    const bf16x8 vf = __builtin_shufflevector(lo, hi, 0, 1, 2, 3, 4, 5, 6, 7);
                    if (act0) oacc[0][mt] = mfma16(vf, pf[0][s4], oacc[0][mt]);
                    if (act1) oacc[1][mt] = mfma16(vf, pf[1][s4], oacc[1][mt]);
                }
        }
#undef ATT_PREFETCH
#pragma unroll
        for (int qq = 0; qq < 2; ++qq) {
            float ls = lsum[qq]; ls += shx(ls, 16, lane); ls += shx(ls, 32, lane);
            const float inv = 1.f / ls;
            if (qvalid[qq]) {
#pragma unroll
                for (int mt = 0; mt < 4; ++mt) { u32x2 w; w.x = cvt_pk_bf16(oacc[qq][mt][0] * inv, oacc[qq][mt][1] * inv); w.y = cvt_pk_bf16(oacc[qq][mt][2] * inv, oacc[qq][mt][3] * inv);
                    *(u32x2*)(Y + qrow[qq] * D + h * 64 + 16 * mt + 4 * fq) = w; }
            }
        }
    }
}

#define XB_TMO      128
#define XB_XCNT(j)  (256  + 64 * (j))
#define XB_XSUB(j)  (1280 + 64 * (j))
#define XB_XGEN(j)  (2304 + 64 * (j))
#define XB_TOP      3328
#define XB_TOPGEN   3392
#define XB_SPIN_CAP (1u << 20)
DI unsigned xb_ld(unsigned* p)              { return __hip_atomic_load(p, __ATOMIC_RELAXED, __HIP_MEMORY_SCOPE_AGENT); }
DI unsigned xb_add(unsigned* p, unsigned v) { return __hip_atomic_fetch_add(p, v, __ATOMIC_RELAXED, __HIP_MEMORY_SCOPE_AGENT); }
DI unsigned xb_xcc_id() { return (unsigned)__builtin_amdgcn_s_getreg((3 << 11) | 20) & 0xFu; }
#define XB_SPIN(cond, bar) do { unsigned _sp = 0; while (cond) { __builtin_amdgcn_s_sleep(1); \
    if ((++_sp & 255u) == 0u) { if (xb_ld(&(bar)[XB_TMO])) break; if (_sp > XB_SPIN_CAP) { atomicAdd(&(bar)[XB_TMO], 1u); break; } } } } while (0)
struct XcdBarrier { unsigned* bar; unsigned x; volatile LAS unsigned* st; };
DI XcdBarrier xcd_barrier_post(unsigned* bar, volatile LAS unsigned* st) {
    XcdBarrier b; b.bar = bar; b.x = xb_xcc_id(); b.st = st;
    if (threadIdx.x == 0) (void)xb_add(&bar[XB_XCNT(b.x)], 1u);
    return b;
}
DI void xcd_barrier_complete(unsigned* bar, unsigned x, unsigned& nloc, unsigned& nx) {
    const unsigned G = gridDim.x * gridDim.y * gridDim.z;
    unsigned sum, cnt, mine, sp = 0u;
    for (;;) {
        sum = 0u; cnt = 0u; mine = 0u;
#pragma unroll
        for (unsigned j = 0; j < 16; ++j) { const unsigned c = xb_ld(&bar[XB_XCNT(j)]); sum += c; cnt += (c > 0u) ? 1u : 0u; mine = (j == x) ? c : mine; }
        if (sum == G) break;
        __builtin_amdgcn_s_sleep(1);
        if ((++sp & 255u) == 0u) { if (xb_ld(&bar[XB_TMO])) break; if (sp > XB_SPIN_CAP) { atomicAdd(&bar[XB_TMO], 1u); break; } }
    }
    nloc = mine > 0u ? mine : 1u; nx = cnt > 0u ? cnt : 1u;
}
DI void xcd_barrier(const XcdBarrier& b) {
    asm volatile("s_waitcnt vmcnt(0)" ::: "memory");
    __syncthreads();
    if (threadIdx.x == 0) {
        unsigned* bar = b.bar;
        __builtin_amdgcn_s_waitcnt(0);
        unsigned nloc = b.st[0], nx = b.st[1];
        if (nloc == 0u) { xcd_barrier_complete(bar, b.x, nloc, nx); b.st[0] = nloc; b.st[1] = nx; }
        const unsigned old = xb_add(&bar[XB_XSUB(b.x)], 1u);
        const unsigned gen = old / nloc;
        if (old + 1u == (gen + 1u) * nloc) {
            __builtin_amdgcn_fence(__ATOMIC_RELEASE, "agent");
            asm volatile("s_waitcnt vmcnt(0)" ::: "memory");
            const unsigned og = xb_add(&bar[XB_TOP], 1u);
            const unsigned tg = og / nx;
            if (og + 1u == (tg + 1u) * nx) xb_add(&bar[XB_TOPGEN], 1u);
            else XB_SPIN(xb_ld(&bar[XB_TOPGEN]) == tg, bar);
            __builtin_amdgcn_fence(__ATOMIC_ACQUIRE, "agent");
            xb_add(&bar[XB_XGEN(b.x)], 1u);
            asm volatile("s_waitcnt vmcnt(0)" ::: "memory");
        } else {
            XB_SPIN(xb_ld(&bar[XB_XGEN(b.x)]) == gen, bar);
            __builtin_amdgcn_fence(__ATOMIC_ACQUIRE, "agent");
            asm volatile("s_waitcnt vmcnt(0)" ::: "memory");
        }
    }
    __syncthreads();
}

constexpr int NSTEP_L = 9, NPHASE = 1 + NSTEP_L * DEPTH + 1;

__global__ void __launch_bounds__(NTHR) mega(Params p) {
    extern __shared__ __attribute__((aligned(16))) unsigned char lds_raw[];
    LAS unsigned char* lds = (LAS unsigned char*)lds_raw;
    cg::grid_group grid = cg::this_grid();
    LAS unsigned* stw = (LAS unsigned*)(lds + LDS_BYTES - 32);
    if (threadIdx.x == 0) { stw[0] = 0u; stw[1] = 0u; }
    __syncthreads();
    const XcdBarrier xb = xcd_barrier_post((unsigned*)(p.ws + WS_BAR), (volatile LAS unsigned*)stw);
    for (int ph = p.ph_lo; ph < p.ph_hi; ++ph) {
        if (p.ph_lo < 0) grid.sync();
        if (ph > p.ph_lo) xcd_barrier(xb);
        size_t zoff = 0; asm volatile("" : "+s"(zoff));
        unsigned char* ws = p.ws + zoff;
        float* H32 = (float*)(ws + WS_H32); bf16_t* H16 = (bf16_t*)(ws + WS_H16); float* ST = (float*)(ws + WS_H16);
        bf16_t* ACT = (bf16_t*)(ws + WS_BIG); bf16_t* PROJ = (bf16_t*)(ws + WS_BIG); bf16_t* Y = (bf16_t*)(ws + WS_BIG + SZ_PROJ);
        float* FDT = (float*)(ws + WS_FDT); float* CC = (float*)(ws + WS_CC); float* CD = (float*)(ws + WS_CD);
        float* STAT = (float*)(ws + WS_STAT);
        if (ph == 0) { prep_phase(lds, p); continue; }
        if (ph == NPHASE - 1) { ln_phase(H32, H16, p.in[23] + (DEPTH - 1) * D, p.in[24] + (DEPTH - 1) * D, p.out); continue; }
        const int l = (ph - 1) / NSTEP_L, s = (ph - 1) % NSTEP_L;
#ifdef REP_S
        for (int rep = 0; rep < ((s == REP_S) ? 2 : 1); ++rep) {
        if (rep) xcd_barrier(xb);
#else
        { const int rep = 0; (void)rep;
#endif
        switch (s) {
        case 0: case 7: {
            const int f = (s == 7), q = l * 2 + f, stg = 3 * l + 2 * f;
            const float* st = stg ? STAT + (size_t)stg * R * 2 : nullptr;
            const bf16_t* Wt = (const bf16_t*)(ws + WS_WGU + (size_t)q * SZ_WGU);
            const float* GW = (const float*)(ws + WS_GWGU) + (size_t)q * 2 * FF; const float* BW = (const float*)(ws + WS_BWGU) + (size_t)q * 2 * FF;
            pg8::Gemm g{H16, Wt, 2 * FF, D}; pg8::StaticOrder S; S.init(2 * FF, gridDim.x, blockIdx.x);
            pg8::EpiGU E{ACT, st, GW, BW};
            pg8::gemm_phase<pg8::EpiGU>(lds, g, S, E);
            skinny_phase<0>(lds, H16, D, Wt, FF / 16, ACT, nullptr, 0.f, st, GW, BW, nullptr, nullptr, nullptr, nullptr);
        } break;
        case 1: case 8: {
            const int f = (s == 8), q = l * 2 + f, stg = 3 * l + 2 * f;
            const float* st = stg ? STAT + (size_t)stg * R * 2 : nullptr;
            const float* lg = f ? p.in[18] + l * D : (l ? p.in[23] + (l - 1) * D : nullptr);
            const float* lb = f ? p.in[19] + l * D : (l ? p.in[24] + (l - 1) * D : nullptr);
            float* sto = STAT + (size_t)(stg + 1) * R * 2;
            const bf16_t* Wt = (const bf16_t*)(ws + WS_WDN + (size_t)q * SZ_WDN);
            pg8::Gemm g{ACT, Wt, D, FF}; pg8::StaticOrder S; S.init(D, gridDim.x, blockIdx.x);
            pg8::EpiRes<true> E{H32, H16, st, lg, lb, sto};
            pg8::gemm_phase<pg8::EpiRes<true>>(lds, g, S, E);
            skinny_phase<1>(lds, ACT, FF, Wt, D / 32, nullptr, H32, 0.5f, st, nullptr, nullptr, lg, lb, sto, H16);
        } break;
        case 2: {
            const float* st = STAT + (size_t)(3 * l + 1) * R * 2;
            const bf16_t* Wt = (const bf16_t*)(ws + WS_WIN + (size_t)l * SZ_WIN);
            const float* GW = (const float*)(ws + WS_GWIN) + (size_t)l * NIN; const float* BW = (const float*)(ws + WS_BWIN) + (size_t)l * NIN;
            pg8::Gemm g{H16, Wt, NIN, D}; pg8::StaticOrder S; S.init(NIN, gridDim.x, blockIdx.x);
            pg8::EpiWin E{PROJ, FDT, st, GW, BW};
            pg8::gemm_phase<pg8::EpiWin>(lds, g, S, E);
            skinny_phase<2>(lds, H16, D, Wt, NIN / 32, PROJ, FDT, 0.f, st, GW, BW, nullptr, nullptr, nullptr, nullptr);
        } break;
        case 3: {
            unsigned* ctr = (unsigned*)(ws + WS_Q) + ph + 32 * rep;
            LAS int* slot = (LAS int*)(lds + LDS_BYTES - 16);
            for (;;) {
                __syncthreads();
                if (threadIdx.x == 0) *slot = (int)atomicAdd(ctr, 1u);
                __syncthreads();
                const int it = *slot;
                constexpr int NSA = NBATCH * NBLK * 2, NPL = NBATCH * NBLK * 4;
                if (it >= NSA + NPL + 32) break;
                if (it < NSA) ssda_item(it, lds, PROJ, FDT, p.in[11] + l * 4 * 1536, p.in[12] + l * 1536, p.in[13] + l * 16, p.in[14] + l * 16, ST, CD);
                else if (it < NSA + NPL) pool_item(it - NSA, lds, PROJ, (const bf16_t*)(ws + WS_PWT) + (size_t)l * 4 * 128 * 128, p.in[10] + l * 512, Y);
                else cumsum_item(lds, FDT, p.in[8] + l * 8, CC, it - NSA - NPL);
            }
        } break;
        case 4:
            scan_phase(ST, CD);
            break;
        case 5: {
            unsigned* ctr = (unsigned*)(ws + WS_Q) + ph + 32 * rep;
            LAS int* slot = (LAS int*)(lds + LDS_BYTES - 16);
            for (;;) {
                __syncthreads();
                if (threadIdx.x == 0) *slot = (int)atomicAdd(ctr, 1u);
                __syncthreads();
                const int it = *slot;
                constexpr int NSC = NBATCH * NBLK * 2, NAT = 32 * 17;
                if (it >= NSC + NAT) break;
                if (it < NSC) ssdc_item(it, lds, PROJ, FDT, p.in[11] + l * 4 * 1536, p.in[12] + l * 1536, p.in[13] + l * 16, p.in[14] + l * 16, p.in[15] + l * 16, p.in[16] + l * 1024, ST, Y);
                else attn_item(it - NSC, lds, PROJ, CC, Y);
            }
        } break;
        case 6: {
            const float* st = STAT + (size_t)(3 * l + 1) * R * 2; float* sto = STAT + (size_t)(3 * l + 2) * R * 2;
            const bf16_t* Wt = (const bf16_t*)(ws + WS_WOUT + (size_t)l * SZ_WOUT);
            pg8::Gemm g{Y, Wt, D, D}; pg8::StaticOrder S; S.init(D, gridDim.x, blockIdx.x);
            pg8::EpiRes<false> E{H32, H16, st, p.in[5] + l * D, p.in[6] + l * D, sto};
            pg8::gemm_phase<pg8::EpiRes<false>>(lds, g, S, E);
            skinny_phase<1>(lds, Y, D, Wt, D / 32, nullptr, H32, 1.0f, st, nullptr, nullptr, p.in[5] + l * D, p.in[6] + l * D, sto, H16);
        } break;
        }
        }
    }
}

extern "C" void kernel_launch(void* const* d_in, const int* in_sizes, int n_in, void* d_out, int out_size, void* d_ws, size_t ws_size, hipStream_t stream) {
    static int grid = 0;
    if (grid == 0) {
        if (n_in != 25 || ws_size < WS_END) { fprintf(stderr, "kernel_launch: need 25 inputs and %zu bytes of workspace (got %d, %zu)\n", (size_t)WS_END, n_in, ws_size); grid = -1; return; }
        int dev = 0, cus = 0, per_cu = 0;
        (void)hipGetDevice(&dev);
        (void)hipDeviceGetAttribute(&cus, hipDeviceAttributeMultiprocessorCount, dev);
        if (hipFuncSetAttribute((const void*)mega, hipFuncAttributeMaxDynamicSharedMemorySize, LDS_BYTES) != hipSuccess) fprintf(stderr, "kernel_launch: hipFuncSetAttribute failed\n");
        if (hipOccupancyMaxActiveBlocksPerMultiprocessor(&per_cu, (const void*)mega, NTHR, LDS_BYTES) != hipSuccess || per_cu < 1) { fprintf(stderr, "kernel_launch: occupancy query says %d\n", per_cu); per_cu = 1; }
        (void)hipGetLastError();
        grid = cus * per_cu;
        if (grid != 256) { fprintf(stderr, "kernel_launch: this build's per-phase folded-LN tables assume a 256-workgroup grid (one per CU of a 256-CU device); got %d\n", grid); grid = -1; return; }
    }
    if (grid < 0) return;
    (void)hipMemsetAsync((unsigned char*)d_ws + WS_ZERO, 0, ZERO_BYTES, stream);
    Params p{};
    for (int i = 0; i < 25; ++i) p.in[i] = (const float*)d_in[i];
    p.out = (float*)d_out; p.ws = (unsigned char*)d_ws;
#if PER_PHASE_LAUNCH
    for (int ph = 0; ph < NPHASE; ++ph) { p.ph_lo = ph; p.ph_hi = ph + 1; hipLaunchKernelGGL(mega, dim3(grid), dim3(NTHR), LDS_BYTES, stream, p); }
#else
    p.ph_lo = 0; p.ph_hi = NPHASE;
    void* args[] = {&p};
    hipError_t e = hipLaunchCooperativeKernel((const void*)mega, dim3(grid), dim3(NTHR), args, LDS_BYTES, stream);
    if (e != hipSuccess) fprintf(stderr, "cooperative launch failed: %s (grid %d)\n", hipGetErrorString(e), grid);
#endif
}
```

```cpp
#include <hip/hip_runtime.h>
#include <hip/hip_cooperative_groups.h>
#include <cstdio>
namespace cg = cooperative_groups;

#ifndef PER_PHASE_LAUNCH
#define PER_PHASE_LAUNCH 0
#endif

#define LAS __attribute__((address_space(3)))
#define DI __device__ __forceinline__
typedef unsigned short bf16_t;
typedef short bf16x8 __attribute__((ext_vector_type(8)));
typedef short s16x4 __attribute__((ext_vector_type(4)));
typedef float f32x4 __attribute__((ext_vector_type(4)));
typedef unsigned u32x4 __attribute__((ext_vector_type(4)));
typedef unsigned u32x2 __attribute__((ext_vector_type(2)));

constexpr int D = 2048, NBATCH = 4, SEQ = 4096, NMETA = 16, LT = SEQ + NMETA  , R = NBATCH * LT  ;
constexpr int FF = 5632, NIN = 4864  , NBLK = 33, NTHR = 512, DEPTH = 2;
constexpr int C_Q = 0, C_K = 512, C_V = 1024, C_U = 1536, C_Z = 2048, C_X = 3072, C_F = 4608;
constexpr float ALPHA = 1.41421356237309515f, LN_EPS = 1e-5f, RMS_EPS = 1e-5f, LOG2E = 1.4426950408889634f;
constexpr int LDS_BYTES = 159744;

constexpr size_t SZ_WGU = (size_t)2 * FF * D * 2, SZ_WDN = (size_t)D * FF * 2, SZ_WIN = (size_t)NIN * D * 2, SZ_WOUT = (size_t)D * D * 2, SZ_PWT = (size_t)4 * 128 * 128 * 2;
constexpr size_t WS_WGU = 0;
constexpr size_t WS_WDN = WS_WGU + 4 * SZ_WGU;
constexpr size_t WS_WIN = WS_WDN + 4 * SZ_WDN;
constexpr size_t WS_WOUT = WS_WIN + 2 * SZ_WIN;
constexpr size_t WS_PWT = WS_WOUT + 2 * SZ_WOUT;
constexpr size_t WS_H32 = WS_PWT + 2 * SZ_PWT;
constexpr size_t WS_H16 = WS_H32 + (size_t)R * D * 4;
constexpr size_t SZ_ST = (size_t)NBATCH * NBLK * 16 * 64 * 128 * 4;
constexpr size_t WS_BIG = WS_H16 + SZ_ST;
constexpr size_t SZ_PROJ = (size_t)R * NIN * 2, SZ_Y = (size_t)R * D * 2;
constexpr size_t WS_FDT = WS_BIG + SZ_PROJ + SZ_Y;
constexpr size_t WS_CC = WS_FDT + (size_t)R * 32 * 4;
constexpr size_t WS_CD = WS_CC + (size_t)NBATCH * 8 * LT * 4;
constexpr size_t WS_ZERO = WS_CD + (size_t)NBATCH * NBLK * 16 * 4 + 256;
constexpr size_t WS_Q = WS_ZERO;
constexpr size_t WS_STAT = WS_Q + 256;
constexpr size_t WS_GWGU = WS_STAT + (size_t)7 * R * 2 * 4;
constexpr size_t WS_BWGU = WS_GWGU + (size_t)4 * 2 * FF * 4;
constexpr size_t WS_GWIN = WS_BWGU + (size_t)4 * 2 * FF * 4;
constexpr size_t WS_BWIN = WS_GWIN + (size_t)2 * NIN * 4;
constexpr size_t WS_BAR = WS_BWIN + (size_t)2 * NIN * 4;
constexpr size_t WS_END = WS_BAR + 3456 * 4 + 256 - (3456 * 4) % 256;
constexpr size_t ZERO_BYTES = WS_END - WS_ZERO;
static_assert((size_t)R * FF * 2 <= SZ_PROJ + SZ_Y, "ACT fits");
static_assert(SZ_ST >= (size_t)R * D * 2, "H16 fits");

typedef float f32x2c __attribute__((ext_vector_type(2)));
typedef __bf16 bf16x2c __attribute__((ext_vector_type(2)));
DI unsigned cvt_pk_bf16(float lo, float hi) { const f32x2c v = {lo, hi}; return __builtin_bit_cast(unsigned, __builtin_convertvector(v, bf16x2c)); }
DI float bf2f(bf16_t v) { return __uint_as_float(((unsigned)v) << 16); }
DI bf16_t f2bf(float f) { return (bf16_t)(cvt_pk_bf16(f, 0.f) & 0xffffu); }
DI float silu_f(float x) { return x * __builtin_amdgcn_rcpf(1.f + __expf(-x)); }
DI float softplus_f(float x) { return x > 20.f ? x : __logf(1.f + __expf(x)); }
DI float shx(float v, int mask, int lane) { return __uint_as_float((unsigned)__builtin_amdgcn_ds_bpermute((lane ^ mask) << 2, (int)__float_as_uint(v))); }
DI float wave_sum(float v, int lane) {
#pragma unroll
    for (int o = 1; o < 64; o <<= 1) v += shx(v, o, lane);
    return v;
}
DI float wave_incl_scan(float x, int lane) {
#pragma unroll
    for (int o = 1; o < 64; o <<= 1) { const float v = __uint_as_float((unsigned)__builtin_amdgcn_ds_bpermute((lane - o) << 2, (int)__float_as_uint(x))); if (lane >= o) x += v; }
    return x;
}
DI f32x4 mfma16(bf16x8 a, bf16x8 b, f32x4 c) { return __builtin_amdgcn_mfma_f32_16x16x32_bf16(a, b, c, 0, 0, 0); }
DI int memrow_meta(int r) { return (r >> 4) * LT + (r & 15); }
#define RLF(v, k) __uint_as_float(__builtin_amdgcn_readlane(__float_as_uint(v), (k)))
#define LDS_WAIT() asm volatile("s_waitcnt lgkmcnt(0)" ::: "memory")
typedef float f32x2 __attribute__((ext_vector_type(2)));
DI f32x2 row_stats(const float* st, size_t row) {
    float rstd = 1.f, mu = 0.f;
    if (st) { const f32x2 sq = *(const f32x2*)(st + row * 2); mu = sq.x * (1.f / D); const float var = fmaxf(sq.y * (1.f / D) - mu * mu, 0.f); rstd = __builtin_amdgcn_rsqf(var + LN_EPS); }
    return (f32x2){rstd, mu};
}

namespace pg8 {
constexpr int BM = 256, BK = 64, HALF = 128, HTB = HALF * BK * 2, NXCD = 8, WGM = 8;
DI int lds_byte(int r, int c) { const int st = (r >> 4) * 2 + (c >> 5), rr = r & 15, cc = c & 31, ob = rr * 64 + cc * 2; return st * 1024 + (ob ^ (((ob >> 9) & 1) << 5)); }
DI void stage_rc(int b, int& Rr, int& Cc) { const int st = b / 1024, sb = b % 1024, swz = sb ^ (((sb >> 9) & 1) << 5); Rr = (st >> 1) * 16 + swz / 64; Cc = (st & 1) * 32 + (swz % 64) / 2; }
DI int perm32(int rho) { const int n = rho >> 4, i = rho & 15; return 8 * (i >> 2) + 4 * n + (i & 3); }
struct Unit { int pm, pn; };
struct Gemm { const bf16_t* A; const bf16_t* Bt; int N, K; };
DI int rowbase(int pm) { return (pm >> 4) * LT + NMETA + (pm & 15) * 256; }
struct StaticOrder {
    int nM, nN, nwg, G, c;
    DI void init(int N, int G_, int c_) { nM = 64; nN = N / BM; nwg = nM * nN; G = G_; c = c_; }
    DI bool next(int i, Unit& u) const {
        const int L = __builtin_amdgcn_readfirstlane(i * G + c); if (L >= nwg) return false;
        int wgid = L; { const int q = nwg / NXCD, r = nwg % NXCD, xcd = wgid % NXCD, off = wgid / NXCD; wgid = (xcd < r ? xcd * (q + 1) : r * (q + 1) + (xcd - r) * q) + off; }
        const int nig = WGM * nN, gid = wgid / nig, fm = gid * WGM, gsz = (nM - fm) < WGM ? (nM - fm) : WGM;
        u.pm = fm + ((wgid % nig) % gsz); u.pn = (wgid % nig) / gsz; return true;
    }
};

constexpr int TAB_OFF = 131072, TABC_OFF = 131072 + 2048, TABC_BYTES = 2048, TAB_MAXU = 11;
struct EpiGU {
    static constexpr bool PERM = true, TAB = true; bf16_t* O; const float* ST; const float* GW; const float* BW;
    DI f32x2 row_fetch(int pm, int tid) const { const f32x2 rs = row_stats(ST, (size_t)(rowbase(pm) + (tid & 255))); return (f32x2){rs.x, rs.x * rs.y}; }
    DI float col_fetch(int pn, int tid) const { return tid < 256 ? GW[pn * 256 + tid] : BW[pn * 256 + tid - 256]; }
    DI void operator()(const f32x4 (&acc)[2][2][4][2], const Unit& u, int wr, int wc, int fr, int fq, const LAS unsigned char* tabR, const LAS unsigned char* tabC) const {
        asm volatile("" : "+v"(fr), "+v"(fq));
        const int row0 = rowbase(u.pm) + wr * 64 + fr, col0 = u.pn * 128 + wc * 32 + 8 * fq, lc0 = wc * 32 + 8 * fq;
        const LAS f32x2* tr = (const LAS f32x2*)tabR; const LAS float* tg = (const LAS float*)tabC; const LAS float* tb = (const LAS float*)(tabC + 1024);
        f32x4 gw[2][2], bw[2][2];
#pragma unroll
        for (int bj = 0; bj < 2; ++bj)
#pragma unroll
            for (int n = 0; n < 2; ++n) { gw[bj][n] = *(const LAS f32x4*)(tg + lc0 + bj * HALF + 4 * n); bw[bj][n] = *(const LAS f32x4*)(tb + lc0 + bj * HALF + 4 * n); }
#pragma unroll
        for (int ai = 0; ai < 2; ++ai)
#pragma unroll
            for (int m = 0; m < 4; ++m) {
                const size_t row = (size_t)(row0 + ai * HALF + m * 16);
                const f32x2 rs = tr[ai * HALF + wr * 64 + m * 16 + fr]; const float rstd = rs.x, rm = rs.y;
                bf16_t* rowp = O + row * FF + col0;
                const f32x4 g0 = acc[ai][0][m][0] * rstd - gw[0][0] * rm + bw[0][0], g1 = acc[ai][0][m][1] * rstd - gw[0][1] * rm + bw[0][1];
                const f32x4 u0 = acc[ai][1][m][0] * rstd - gw[1][0] * rm + bw[1][0], u1 = acc[ai][1][m][1] * rstd - gw[1][1] * rm + bw[1][1];
                const f32x4 t0 = g0 * (-LOG2E), t1 = g1 * (-LOG2E);
                f32x4 e0, e1;
#pragma unroll
                for (int j = 0; j < 4; ++j) { e0[j] = __builtin_amdgcn_exp2f(t0[j]); e1[j] = __builtin_amdgcn_exp2f(t1[j]); }
                e0 = e0 + 1.f; e1 = e1 + 1.f;
                f32x4 r0, r1;
#pragma unroll
                for (int j = 0; j < 4; ++j) { r0[j] = __builtin_amdgcn_rcpf(e0[j]); r1[j] = __builtin_amdgcn_rcpf(e1[j]); }
                const f32x4 v0 = (g0 * u0) * r0, v1 = (g1 * u1) * r1;
                u32x4 w; w.x = cvt_pk_bf16(v0[0], v0[1]); w.y = cvt_pk_bf16(v0[2], v0[3]); w.z = cvt_pk_bf16(v1[0], v1[1]); w.w = cvt_pk_bf16(v1[2], v1[3]);
                *(u32x4*)rowp = w;
            }
    }
};
template <bool HALFC> struct EpiRes {
    static constexpr bool PERM = false, TAB = false; static constexpr float coef = HALFC ? 0.5f : 1.0f; float* H; bf16_t* H16; const float* STin; const float* lg; const float* lb; float* STout;
    DI f32x2 row_fetch(int, int) const { return (f32x2){0.f, 0.f}; }
    DI float col_fetch(int, int) const { return 0.f; }
    DI void operator()(const f32x4 (&acc)[2][2][4][2], const Unit& u, int wr, int wc, int fr, int fq, const LAS unsigned char*, const LAS unsigned char*) const {
        asm volatile("" : "+v"(fr), "+v"(fq));
        const int row0 = rowbase(u.pm) + wr * 64 + fr, col0 = u.pn * BM + wc * 32 + 4 * fq;
        const bool has = STin != nullptr;
#pragma unroll
        for (int ai = 0; ai < 2; ++ai)
#pragma unroll
            for (int mp = 0; mp < 2; ++mp) {
                f32x4 hv[2][2][2]; f32x2 rsv2[2]; f32x4 gq[2][2], bq[2][2];
#pragma unroll
                for (int mm = 0; mm < 2; ++mm) { rsv2[mm] = row_stats(STin, (size_t)(row0 + ai * HALF + (2 * mp + mm) * 16));
                    const float* rowp = H + (size_t)(row0 + ai * HALF + (2 * mp + mm) * 16) * D + col0;
#pragma unroll
                    for (int bj = 0; bj < 2; ++bj)
#pragma unroll
                        for (int n = 0; n < 2; ++n) hv[mm][bj][n] = *(const f32x4*)(rowp + bj * HALF + n * 16); }
#pragma unroll
                for (int bj = 0; bj < 2; ++bj)
#pragma unroll
                    for (int n = 0; n < 2; ++n) {
                        gq[bj][n] = (f32x4){1.f, 1.f, 1.f, 1.f}; bq[bj][n] = (f32x4){0.f, 0.f, 0.f, 0.f};
                        if (has) { gq[bj][n] = *(const f32x4*)(lg + col0 + bj * HALF + n * 16); bq[bj][n] = *(const f32x4*)(lb + col0 + bj * HALF + n * 16); } }
#pragma unroll
                for (int mm = 0; mm < 2; ++mm) {
                    const int m = 2 * mp + mm;
                    const size_t row = (size_t)(row0 + ai * HALF + m * 16);
                    const float rstd = rsv2[mm].x, mu = rsv2[mm].y;
                    float* rowp = H + row * D + col0; bf16_t* row16 = H16 + row * D + col0;
                    float ps = 0.f, pq = 0.f;
#pragma unroll
                    for (int bj = 0; bj < 2; ++bj)
#pragma unroll
                        for (int n = 0; n < 2; ++n) {
                            const f32x4 h = (hv[mm][bj][n] - mu) * rstd * gq[bj][n] + bq[bj][n];
                            const f32x4 xn = h * ALPHA + acc[ai][bj][m][n] * coef;
                            *(f32x4*)(rowp + bj * HALF + n * 16) = xn;
                            u32x2 w; w.x = cvt_pk_bf16(xn[0], xn[1]); w.y = cvt_pk_bf16(xn[2], xn[3]); *(u32x2*)(row16 + bj * HALF + n * 16) = w;
                            ps += (xn[0] + xn[1]) + (xn[2] + xn[3]); pq += (xn[0] * xn[0] + xn[1] * xn[1]) + (xn[2] * xn[2] + xn[3] * xn[3]);
                        }
                    ps += shx(ps, 16, (fr + 16 * fq)); ps += shx(ps, 32, (fr + 16 * fq)); pq += shx(pq, 16, (fr + 16 * fq)); pq += shx(pq, 32, (fr + 16 * fq));
                    if (fq == 0) { unsafeAtomicAdd(STout + row * 2, ps); unsafeAtomicAdd(STout + row * 2 + 1, pq); }
                }
            }
    }
};
struct EpiWin {
    static constexpr bool PERM = true, TAB = true; bf16_t* P; float* FDT; const float* ST; const float* GW; const float* BW;
    DI f32x2 row_fetch(int pm, int tid) const { const f32x2 rs = row_stats(ST, (size_t)(rowbase(pm) + (tid & 255))); return (f32x2){rs.x, rs.x * rs.y}; }
    DI float col_fetch(int pn, int tid) const { return tid < 256 ? GW[pn * 256 + tid] : BW[pn * 256 + tid - 256]; }
    DI void operator()(const f32x4 (&acc)[2][2][4][2], const Unit& u, int wr, int wc, int fr, int fq, const LAS unsigned char* tabR, const LAS unsigned char* tabC) const {
        asm volatile("" : "+v"(fr), "+v"(fq));
        const int row0 = rowbase(u.pm) + wr * 64 + fr, col0 = u.pn * BM + wc * 32 + 8 * fq, lc0 = wc * 32 + 8 * fq;
        const LAS f32x2* tr = (const LAS f32x2*)tabR; const LAS float* tg = (const LAS float*)tabC; const LAS float* tb = (const LAS float*)(tabC + 1024);
        f32x4 gw[2][2], bw[2][2];
#pragma unroll
        for (int bj = 0; bj < 2; ++bj)
#pragma unroll
            for (int n = 0; n < 2; ++n) { gw[bj][n] = *(const LAS f32x4*)(tg + lc0 + bj * HALF + 4 * n); bw[bj][n] = *(const LAS f32x4*)(tb + lc0 + bj * HALF + 4 * n); }
#pragma unroll
        for (int ai = 0; ai < 2; ++ai)
#pragma unroll
            for (int m = 0; m < 4; ++m) {
                const size_t row = (size_t)(row0 + ai * HALF + m * 16);
                const f32x2 rs = tr[ai * HALF + wr * 64 + m * 16 + fr]; const float rstd = rs.x, rm = rs.y;
                bf16_t* rowp = P + row * NIN + col0;
                f32x4 v[2][2];
#pragma unroll
                for (int bj = 0; bj < 2; ++bj) {
                    v[bj][0] = acc[ai][bj][m][0] * rstd - gw[bj][0] * rm + bw[bj][0]; v[bj][1] = acc[ai][bj][m][1] * rstd - gw[bj][1] * rm + bw[bj][1];
                    u32x4 w; w.x = cvt_pk_bf16(v[bj][0][0], v[bj][0][1]); w.y = cvt_pk_bf16(v[bj][0][2], v[bj][0][3]); w.z = cvt_pk_bf16(v[bj][1][0], v[bj][1][1]); w.w = cvt_pk_bf16(v[bj][1][2], v[bj][1][3]);
                    *(u32x4*)(rowp + bj * HALF) = w;
                }
                if (u.pn == 18 && wc == 0 && fq < 3) { float* f = FDT + row * 32 + 8 * fq; *(f32x4*)f = v[0][0]; *(f32x4*)(f + 4) = v[0][1]; }
            }
    }
};

#ifndef PG8_SP2
#define PG8_SP2 true
#endif
#ifndef PG8_ALIGN
#define PG8_ALIGN true
#endif
template <class Epi, bool SP2 = PG8_SP2, bool ALIGN_EPI = PG8_ALIGN>
DI void gemm_phase(LAS unsigned char* lds, const Gemm g, const StaticOrder& S, const Epi& E) {
    int tid_ = threadIdx.x; asm volatile("" : "+v"(tid_));
    const int tid = tid_, wid = __builtin_amdgcn_readfirstlane(tid >> 6), lane = tid & 63, wr = wid >> 2, wc = wid & 3, fr = lane & 15, fq = lane >> 4;
    const int K = g.K, nt = K / BK;
    unsigned voffA[2], voffB[2];
#pragma unroll
    for (int i = 0; i < 2; ++i) { int Rr, Cc; stage_rc(tid * 16 + i * 8192, Rr, Cc); const int Rb = Epi::PERM ? ((Rr & ~31) + perm32(Rr & 31)) : Rr;
        voffA[i] = (unsigned)(Rr * K + Cc) * 2u; voffB[i] = (unsigned)(Rb * K + Cc) * 2u; }
    const size_t kstep = (size_t)(BK * 2);
    const size_t hstep = (size_t)HALF * K * 2;
    const size_t tstep = 2 * hstep;
    const size_t rstep = (size_t)K * 2;
    const unsigned ldsw = (unsigned)wid * 1024u;
    const int aoff = lds_byte(wr * 64 + fr, fq * 8), boff = lds_byte(wc * 32 + fr, fq * 8);
#define PG8_SA(b, h) (((b) * 2 + (h)) * HTB)
#define PG8_SB(b, h) ((4 + (b) * 2 + (h)) * HTB)
#define PG8_STAGE(bufoff, gbase, voff) do { _Pragma("unroll") for (int _i = 0; _i < 2; ++_i) \
        __builtin_amdgcn_global_load_lds((const unsigned*)((const char*)(gbase) + (voff)[_i]), (LAS unsigned*)(lds + (bufoff) + ldsw + _i * 8192), 16, 0, 0); } while (0)
#define PG8_LDA(dst, b, h) do { _Pragma("unroll") for (int m = 0; m < 4; ++m) _Pragma("unroll") for (int k = 0; k < 2; ++k) dst[m][k] = *(const LAS bf16x8*)(lds + PG8_SA(b, h) + aoff + m * 2048 + k * 1024); } while (0)
#define PG8_LDB(dst, b, h) do { _Pragma("unroll") for (int n = 0; n < 2; ++n) _Pragma("unroll") for (int k = 0; k < 2; ++k) dst[n][k] = *(const LAS bf16x8*)(lds + PG8_SB(b, h) + boff + n * 2048 + k * 1024); } while (0)
#define PG8_MMA(ai, bj, At, Bt) do { __builtin_amdgcn_s_setprio(1); _Pragma("unroll") for (int m = 0; m < 4; ++m) _Pragma("unroll") for (int n = 0; n < 2; ++n) _Pragma("unroll") for (int k = 0; k < 2; ++k) \
        acc[ai][bj][m][n] = __builtin_amdgcn_mfma_f32_16x16x32_bf16(Bt[n][k], At[m][k], acc[ai][bj][m][n], 0, 0, 0); __builtin_amdgcn_s_setprio(0); } while (0)
#define PG8_WAIT_V(n) asm volatile("s_waitcnt vmcnt(" #n ")" ::: "memory")
#define PG8_WAIT_L(n) asm volatile("s_waitcnt lgkmcnt(" #n ")" ::: "memory")
#define PG8_BAR __builtin_amdgcn_s_barrier()
#define PG8_SCHED __builtin_amdgcn_sched_barrier(0)
    Unit cur, nxt; int ui = 0;
    if (!S.next(0, cur)) return;
    f32x4 acc[2][2][4][2];
#pragma unroll
    for (int a = 0; a < 2; ++a)
#pragma unroll
        for (int b = 0; b < 2; ++b)
#pragma unroll
            for (int m = 0; m < 4; ++m)
#pragma unroll
                for (int n = 0; n < 2; ++n) acc[a][b][m][n] = (f32x4){0.f, 0.f, 0.f, 0.f};
    bf16x8 At[4][2], B0[2][2], B1[2][2];
    const char* cA = (const char*)g.A + (size_t)rowbase(cur.pm) * rstep; const char* cB = (const char*)g.Bt + (size_t)cur.pn * tstep;
    if (Epi::TAB) {
        const f32x2 rv = E.row_fetch(cur.pm, tid);
        float cv[TAB_MAXU];
#pragma unroll
        for (int i = 0; i < TAB_MAXU; ++i) { Unit uu; cv[i] = S.next(i, uu) ? E.col_fetch(uu.pn, tid) : 0.f; }
        if (tid < 256) *(LAS f32x2*)(lds + TAB_OFF + tid * 8) = rv;
#pragma unroll
        for (int i = 0; i < TAB_MAXU; ++i) *(LAS float*)(lds + TABC_OFF + i * TABC_BYTES + tid * 4) = cv[i];
        asm volatile("s_waitcnt vmcnt(0) lgkmcnt(0)" ::: "memory");
    }
    if constexpr (SP2) {
        PG8_STAGE(PG8_SB(0, 0), cB, voffB); PG8_STAGE(PG8_SB(0, 1), cB + hstep, voffB); PG8_STAGE(PG8_SA(0, 0), cA, voffA); PG8_STAGE(PG8_SA(0, 1), cA + hstep, voffA);
        if (wr == 1) PG8_BAR;
        PG8_WAIT_V(2); PG8_BAR;
        PG8_STAGE(PG8_SB(1, 0), cB + kstep, voffB); PG8_STAGE(PG8_SA(1, 0), cA + kstep, voffA); PG8_STAGE(PG8_SB(1, 1), cB + hstep + kstep, voffB);
        PG8_WAIT_V(6); PG8_BAR;
    } else {
    PG8_STAGE(PG8_SB(0, 0), cB, voffB); PG8_STAGE(PG8_SA(0, 0), cA, voffA); PG8_STAGE(PG8_SB(0, 1), cB + hstep, voffB); PG8_STAGE(PG8_SA(0, 1), cA + hstep, voffA);
    if (wr == 1) PG8_BAR;
    PG8_WAIT_V(4); PG8_BAR;
    PG8_STAGE(PG8_SB(1, 0), cB + kstep, voffB); PG8_STAGE(PG8_SA(1, 0), cA + kstep, voffA); PG8_STAGE(PG8_SB(1, 1), cB + hstep + kstep, voffB);
    PG8_WAIT_V(6); PG8_BAR;
    }
    for (;;) {
        const bool has_next = S.next(ui + 1, nxt);
        const char* nA = has_next ? (const char*)g.A + (size_t)rowbase(nxt.pm) * rstep : cA; const char* nB = has_next ? (const char*)g.Bt + (size_t)nxt.pn * tstep : cB;
        for (int t = 0; t < nt; t += 2) {
            const bool last = (t == nt - 2);
            const char* a1 = cA + (size_t)(t + 1) * kstep;
            const char* a2 = last ? nA : cA + (size_t)(t + 2) * kstep; const char* b2 = last ? nB : cB + (size_t)(t + 2) * kstep;
            const char* a3 = a2 + kstep; const char* b3 = b2 + kstep;
            if constexpr (SP2) {
            PG8_LDB(B0, 0, 0); PG8_LDB(B1, 0, 1); PG8_SCHED; PG8_LDA(At, 0, 0); PG8_STAGE(PG8_SA(1, 1), a1 + hstep, voffA);
            PG8_WAIT_V(8); PG8_WAIT_L(0); PG8_BAR; PG8_MMA(0, 0, At, B0); PG8_MMA(0, 1, At, B1); PG8_BAR; PG8_SCHED;
            PG8_LDA(At, 0, 1); PG8_STAGE(PG8_SB(0, 0), b2, voffB); PG8_STAGE(PG8_SB(0, 1), b2 + hstep, voffB); PG8_STAGE(PG8_SA(0, 0), a2, voffA);
            PG8_WAIT_V(8); PG8_WAIT_L(0); PG8_BAR; PG8_MMA(1, 0, At, B0); PG8_MMA(1, 1, At, B1); PG8_BAR; PG8_SCHED;
            PG8_LDB(B0, 1, 0); PG8_LDB(B1, 1, 1); PG8_SCHED; PG8_LDA(At, 1, 0); PG8_STAGE(PG8_SA(0, 1), a2 + hstep, voffA);
            PG8_WAIT_V(8); PG8_WAIT_L(0); PG8_BAR; PG8_MMA(0, 0, At, B0); PG8_MMA(0, 1, At, B1); PG8_BAR; PG8_SCHED;
            PG8_LDA(At, 1, 1); PG8_STAGE(PG8_SB(1, 0), b3, voffB); PG8_STAGE(PG8_SB(1, 1), b3 + hstep, voffB); PG8_STAGE(PG8_SA(1, 0), a3, voffA);
            PG8_WAIT_V(8); PG8_WAIT_L(0); PG8_BAR; PG8_MMA(1, 0, At, B0); PG8_MMA(1, 1, At, B1); PG8_BAR; PG8_SCHED;
            } else {
            PG8_LDB(B0, 0, 0); PG8_SCHED; PG8_LDA(At, 0, 0); PG8_STAGE(PG8_SA(1, 1), a1 + hstep, voffA);
            PG8_WAIT_L(8); PG8_BAR; PG8_WAIT_L(0); PG8_MMA(0, 0, At, B0); PG8_BAR; PG8_SCHED;
            PG8_LDB(B1, 0, 1); PG8_STAGE(PG8_SB(0, 0), b2, voffB);
            PG8_BAR; PG8_WAIT_L(0); PG8_MMA(0, 1, At, B1); PG8_BAR;
            PG8_LDA(At, 0, 1); PG8_STAGE(PG8_SA(0, 0), a2, voffA);
            PG8_BAR; PG8_WAIT_L(0); PG8_MMA(1, 0, At, B0); PG8_BAR; PG8_SCHED;
            PG8_STAGE(PG8_SB(0, 1), b2 + hstep, voffB);
            PG8_WAIT_V(6); PG8_BAR; PG8_MMA(1, 1, At, B1); PG8_BAR;
            PG8_LDB(B0, 1, 0); PG8_SCHED; PG8_LDA(At, 1, 0); PG8_STAGE(PG8_SA(0, 1), a2 + hstep, voffA);
            PG8_WAIT_L(8); PG8_BAR; PG8_WAIT_L(0); PG8_MMA(0, 0, At, B0); PG8_BAR; PG8_SCHED;
            PG8_LDB(B1, 1, 1); PG8_STAGE(PG8_SB(1, 0), b3, voffB);
            PG8_BAR; PG8_WAIT_L(0); PG8_MMA(0, 1, At, B1); PG8_BAR;
            PG8_LDA(At, 1, 1); PG8_STAGE(PG8_SA(1, 0), a3, voffA);
            PG8_BAR; PG8_WAIT_L(0); PG8_MMA(1, 0, At, B0); PG8_BAR; PG8_SCHED;
            PG8_STAGE(PG8_SB(1, 1), b3 + hstep, voffB);
            PG8_WAIT_V(6); PG8_BAR; PG8_MMA(1, 1, At, B1); PG8_BAR;
            }
        }
        if constexpr (ALIGN_EPI) { if (wr == 0) PG8_BAR; }
        E(acc, cur, wr, wc, fr, fq, lds + TAB_OFF, lds + TABC_OFF + (ui < TAB_MAXU ? ui : TAB_MAXU - 1) * TABC_BYTES);
        if (!has_next) break;
#pragma unroll
        for (int a = 0; a < 2; ++a)
#pragma unroll
            for (int b = 0; b < 2; ++b)
#pragma unroll
                for (int m = 0; m < 4; ++m)
#pragma unroll
                    for (int n = 0; n < 2; ++n) acc[a][b][m][n] = (f32x4){0.f, 0.f, 0.f, 0.f};
        cur = nxt; cA = nA; cB = nB; ++ui;
        if constexpr (ALIGN_EPI) { if (wr == 1) PG8_BAR; }
    }
    PG8_WAIT_V(0);
    if constexpr (!ALIGN_EPI) { if (wr == 0) PG8_BAR; }
    PG8_BAR;
#undef PG8_SA
#undef PG8_SB
#undef PG8_STAGE
#undef PG8_LDA
#undef PG8_LDB
#undef PG8_MMA
#undef PG8_WAIT_V
#undef PG8_WAIT_L
#undef PG8_BAR
#undef PG8_SCHED
}
}

template <int KIND>
DI void skinny_phase(LAS unsigned char* lds, const bf16_t* A, int K, const bf16_t* Wt, int nunits, bf16_t* O16, float* O32, float coef,
                     const float* STin, const float* GW, const float* BW, const float* lg, const float* lb, float* STout, bf16_t* H16o) {
    int tid_ = threadIdx.x; asm volatile("" : "+v"(tid_));
    const int tid = tid_, wid = __builtin_amdgcn_readfirstlane(tid >> 6), lane = tid & 63, fr = lane & 15, fq = lane >> 4;
    LAS float* red = (LAS float*)lds;
    LAS float* red2 = (LAS float*)(lds + 16384);
    const int kper = (K / 32) / 8, ks0 = wid * kper, ks1 = ks0 + kper;
    const bf16x8 zero8 = (bf16x8){0, 0, 0, 0, 0, 0, 0, 0};
    for (int u = blockIdx.x; u < nunits; u += gridDim.x) {
        int r0, r1;
        if (KIND == 0) { const int j0 = 16 * u; r0 = (j0 >> 7) * 256 + (j0 & 127); r1 = r0 + 128; } else { r0 = 32 * u; r1 = r0 + 16; }
        f32x4 acc0 = (f32x4){0.f, 0.f, 0.f, 0.f}, acc1 = (f32x4){0.f, 0.f, 0.f, 0.f};
        const bf16_t* a0 = A + (size_t)fr * K + fq * 8;
        const bf16_t* b0 = Wt + (size_t)(r0 + fr) * K + fq * 8;
        const bf16_t* b1 = Wt + (size_t)(r1 + fr) * K + fq * 8;
        bf16x8 ca[4], cb0[4], cb1[4];
#pragma unroll
        for (int s = 0; s < 4; ++s) { const bool ok = ks0 + s < ks1; const int k = (ks0 + s) * 32; ca[s] = zero8; cb0[s] = zero8; cb1[s] = zero8;
            if (ok) { ca[s] = *(const bf16x8*)(a0 + k); cb0[s] = *(const bf16x8*)(b0 + k); cb1[s] = *(const bf16x8*)(b1 + k); } }
        for (int ks = ks0; ks < ks1; ks += 4) {
            bf16x8 na[4], nb0[4], nb1[4];
#pragma unroll
            for (int s = 0; s < 4; ++s) { const bool ok = ks + 4 + s < ks1; const int k = (ks + 4 + s) * 32; na[s] = zero8; nb0[s] = zero8; nb1[s] = zero8;
                if (ok) { na[s] = *(const bf16x8*)(a0 + k); nb0[s] = *(const bf16x8*)(b0 + k); nb1[s] = *(const bf16x8*)(b1 + k); } }
#pragma unroll
            for (int s = 0; s < 4; ++s) { acc0 = mfma16(ca[s], cb0[s], acc0); acc1 = mfma16(ca[s], cb1[s], acc1); }
#pragma unroll
            for (int s = 0; s < 4; ++s) { ca[s] = na[s]; cb0[s] = nb0[s]; cb1[s] = nb1[s]; }
        }
#pragma unroll
        for (int j = 0; j < 4; ++j) { red[(wid * 16 + 4 * fq + j) * 32 + fr] = acc0[j]; red[(wid * 16 + 4 * fq + j) * 32 + 16 + fr] = acc1[j]; }
        __syncthreads();
        { float s = 0.f;
#pragma unroll
          for (int w = 0; w < 8; ++w) s += red[w * 512 + tid];
          red2[tid] = s; }
        __syncthreads();
        const int r = tid >> 5, c = tid & 31;
        const f32x2 rs_ = row_stats(STin, (size_t)r); const float rstd = rs_.x, mu = rs_.y;
        if (KIND == 0) {
            if (c < 16) { const float rm = rstd * mu;
                const float gv = red2[r * 32 + c] * rstd - rm * GW[r0 + c] + BW[r0 + c], uv = red2[r * 32 + 16 + c] * rstd - rm * GW[r1 + c] + BW[r1 + c];
                const bf16_t o = f2bf(silu_f(gv) * uv);
#pragma unroll
                for (int bb = 0; bb < NBATCH; ++bb) O16[((size_t)bb * LT + r) * FF + 16 * u + c] = o; }
        } else if (KIND == 1) {
            const int col = 32 * u + c;
            float h = O32[(size_t)r * D + col]; if (STin) h = (h - mu) * rstd * lg[col] + lb[col];
            const float xn = h * ALPHA + red2[tid] * coef; const bf16_t xb = f2bf(xn);
            float ps = xn, pq = xn * xn;
#pragma unroll
            for (int o = 1; o < 32; o <<= 1) { ps += shx(ps, o, lane); pq += shx(pq, o, lane); }
#pragma unroll
            for (int bb = 0; bb < NBATCH; ++bb) { const size_t row = (size_t)bb * LT + r; O32[row * D + col] = xn; H16o[row * D + col] = xb;
                if (c == 0) { unsafeAtomicAdd(STout + row * 2, ps); unsafeAtomicAdd(STout + row * 2 + 1, pq); } }
        } else {
            const int col = 32 * u + c; const float v = red2[tid] * rstd - rstd * mu * GW[col] + BW[col]; const bf16_t vb = f2bf(v);
#pragma unroll
            for (int bb = 0; bb < NBATCH; ++bb) { const size_t row = (size_t)bb * LT + r; O16[row * NIN + col] = vb;
                if (col >= C_F && col < C_F + 24) O32[row * 32 + col - C_F] = v; }
        }
        __syncthreads();
    }
}

DI void transpose_item(const float* W, int N, int k0, int sc, bf16_t* dst, int K, LAS float* scr, int lane, const float* gvec = nullptr, const float* bvec = nullptr, float* GWp = nullptr, float* BWp = nullptr) {
    float tv[32];
#pragma unroll
    for (int i = 0; i < 32; ++i) { const int kk = 2 * i + (lane >> 5); tv[i] = sc >= 0 ? W[(size_t)(k0 + kk) * N + sc] : 0.f; }
    if (gvec) {
        const float gl = gvec[k0 + lane], bl = bvec[k0 + lane]; float sg = 0.f, sb = 0.f; const bool hi = lane >= 32;
#pragma unroll
        for (int i = 0; i < 32; ++i) {
            const float g0 = RLF(gl, 2 * i), g1 = RLF(gl, 2 * i + 1), b0 = RLF(bl, 2 * i), b1 = RLF(bl, 2 * i + 1);
            sb += tv[i] * (hi ? b1 : b0); tv[i] *= (hi ? g1 : g0); sg += tv[i]; }
        sg += shx(sg, 32, lane); sb += shx(sb, 32, lane);
        if (lane < 32 && sc >= 0) { unsafeAtomicAdd(GWp + lane, sg); unsafeAtomicAdd(BWp + lane, sb); }
    }
#pragma unroll
    for (int i = 0; i < 32; ++i) { const int kk = 2 * i + (lane >> 5); scr[kk * 33 + (lane & 31)] = tv[i]; }
    LDS_WAIT();
    const int c = lane & 7;
#pragma unroll
    for (int j = 0; j < 4; ++j) { const int n = (lane >> 3) + 8 * j; const LAS float* s = scr + (8 * c) * 33 + n;
        u32x4 o; o.x = cvt_pk_bf16(s[0 * 33], s[1 * 33]); o.y = cvt_pk_bf16(s[2 * 33], s[3 * 33]); o.z = cvt_pk_bf16(s[4 * 33], s[5 * 33]); o.w = cvt_pk_bf16(s[6 * 33], s[7 * 33]);
        *(u32x4*)(dst + (size_t)n * K + 8 * c) = o; }
    LDS_WAIT();
}

struct Params { const float* in[25]; float* out; unsigned char* ws; int ph_lo, ph_hi; };

DI void prep_phase(LAS unsigned char* lds, const Params& p) {
    int tid_ = threadIdx.x; asm volatile("" : "+v"(tid_));
    const int tid = tid_, wid = __builtin_amdgcn_readfirstlane(tid >> 6), lane = tid & 63;
    LAS float* scr = (LAS float*)(lds + wid * 8448);
    const int gw = blockIdx.x * 8 + wid, NGW = gridDim.x * 8;
    constexpr int I_GU = 32 * 176, I_DN = 88 * 64, I_IN = 32 * 145, I_OUT = 32 * 64, I_PW = 8;
    constexpr int S0 = 8 * I_GU, S1 = S0 + 4 * I_DN, S2 = S1 + 2 * I_IN, S3 = S2 + 2 * I_OUT, S4 = S3 + 8 * I_PW;
    unsigned char* ws = p.ws;
    for (int it = gw; it < S4; it += NGW) {
        if (it < S0) {
            const int mi = it / I_GU, r = it % I_GU, q = mi >> 1, part = mi & 1, l = q >> 1, f = q & 1;
            const float* W = p.in[(f ? 20 : 2) + part] + (size_t)l * D * FF;
            const int kb = r / 176, nb = r % 176, n0 = 32 * nb;
            bf16_t* WT = (bf16_t*)(ws + WS_WGU + (size_t)q * SZ_WGU);
            const int drow = (n0 >> 7) * 256 + (n0 & 127) + part * 128;
            const float* gvec = f ? p.in[18] + l * D : (l ? p.in[23] + (l - 1) * D : nullptr);
            const float* bvec = f ? p.in[19] + l * D : (l ? p.in[24] + (l - 1) * D : nullptr);
            transpose_item(W, FF, 64 * kb, n0 + (lane & 31), WT + (size_t)drow * D + 64 * kb, D, scr, lane, gvec, bvec,
                           (float*)(ws + WS_GWGU) + (size_t)q * 2 * FF + drow, (float*)(ws + WS_BWGU) + (size_t)q * 2 * FF + drow);
        } else if (it < S1) {
            const int j = it - S0, q = j / I_DN, r = j % I_DN, l = q >> 1, f = q & 1;
            const float* W = p.in[f ? 22 : 4] + (size_t)l * FF * D;
            const int kb = r / 64, nb = r % 64;
            bf16_t* WT = (bf16_t*)(ws + WS_WDN + (size_t)q * SZ_WDN);
            transpose_item(W, D, 64 * kb, 32 * nb + (lane & 31), WT + (size_t)(32 * nb) * FF + 64 * kb, FF, scr, lane);
        } else if (it < S2) {
            const int j = it - S1, l = j / I_IN, r = j % I_IN;
            const float* W = p.in[7] + (size_t)l * D * 4632;
            const int kb = r / 145, nb = r % 145, dn = 32 * nb + (lane & 31);
            int sc;
            if (dn < 1536) sc = dn; else if (dn < 4608) sc = dn + 8; else if (dn < 4616) sc = 1536 + (dn - 4608); else if (dn < 4632) sc = dn; else sc = -1;
            bf16_t* WT = (bf16_t*)(ws + WS_WIN + (size_t)l * SZ_WIN);
            transpose_item(W, 4632, 64 * kb, sc, WT + (size_t)(32 * nb) * D + 64 * kb, D, scr, lane, p.in[5] + l * D, p.in[6] + l * D,
                           (float*)(ws + WS_GWIN) + (size_t)l * NIN + 32 * nb, (float*)(ws + WS_BWIN) + (size_t)l * NIN + 32 * nb);
        } else if (it < S3) {
            const int j = it - S2, l = j / I_OUT, r = j % I_OUT;
            const float* W = p.in[17] + (size_t)l * D * D;
            const int kb = r / 64, nb = r % 64;
            bf16_t* WT = (bf16_t*)(ws + WS_WOUT + (size_t)l * SZ_WOUT);
            transpose_item(W, D, 64 * kb, 32 * nb + (lane & 31), WT + (size_t)(32 * nb) * D + 64 * kb, D, scr, lane);
        } else {
            const int j = it - S3, lg = j / I_PW, r = j % I_PW;
            const float* W = p.in[9] + (size_t)lg * 128 * 128;
            const int kb = r / 4, nb = r % 4;
            bf16_t* WT = (bf16_t*)(ws + WS_PWT) + (size_t)lg * 128 * 128;
            transpose_item(W, 128, 64 * kb, 32 * nb + (lane & 31), WT + (size_t)(32 * nb) * 128 + 64 * kb, 128, scr, lane);
        }
    }
    float* H32 = (float*)(ws + WS_H32); bf16_t* H16 = (bf16_t*)(ws + WS_H16);
    for (int row = gw; row < R; row += NGW) {
        const int b = row / LT, t = row % LT;
        const float* src = t < NMETA ? p.in[1] + (size_t)t * D : p.in[0] + ((size_t)b * SEQ + (t - NMETA)) * D;
#pragma unroll
        for (int j = 0; j < 8; ++j) { const int col = 4 * lane + 256 * j; const f32x4 v = *(const f32x4*)(src + col);
            *(f32x4*)(H32 + (size_t)row * D + col) = v; u32x2 w; w.x = cvt_pk_bf16(v[0], v[1]); w.y = cvt_pk_bf16(v[2], v[3]); *(u32x2*)(H16 + (size_t)row * D + col) = w; }
    }
}

DI void ln_phase(float* H32, bf16_t* H16, const float* g, const float* bta, float* out) {
    int tid_ = threadIdx.x; asm volatile("" : "+v"(tid_));
    const int tid = tid_, wid = __builtin_amdgcn_readfirstlane(tid >> 6), lane = tid & 63;
    const int gw = blockIdx.x * 8 + wid, NGW = gridDim.x * 8;
    f32x4 gv[8], bv[8];
#pragma unroll
    for (int j = 0; j < 8; ++j) { gv[j] = *(const f32x4*)(g + 4 * lane + 256 * j); bv[j] = *(const f32x4*)(bta + 4 * lane + 256 * j); }
    for (int row = gw; row < R; row += NGW) {
        float* hr = H32 + (size_t)row * D;
        f32x4 v[8]; float s = 0.f;
#pragma unroll
        for (int j = 0; j < 8; ++j) { v[j] = *(const f32x4*)(hr + 4 * lane + 256 * j); s += (v[j][0] + v[j][1]) + (v[j][2] + v[j][3]); }
        const float mean = wave_sum(s, lane) * (1.f / D); float s2 = 0.f;
#pragma unroll
        for (int j = 0; j < 8; ++j) { v[j] = v[j] - mean; s2 += (v[j][0] * v[j][0] + v[j][1] * v[j][1]) + (v[j][2] * v[j][2] + v[j][3] * v[j][3]); }
        const float rstd = __builtin_amdgcn_rsqf(wave_sum(s2, lane) * (1.f / D) + LN_EPS);
        if (out) {
            const int b = row / LT, t = row % LT;
            if (t >= NMETA) { float* orow = out + ((size_t)b * SEQ + (t - NMETA)) * D;
#pragma unroll
                for (int j = 0; j < 8; ++j) *(f32x4*)(orow + 4 * lane + 256 * j) = v[j] * rstd * gv[j] + bv[j]; }
        } else {
            bf16_t* br = H16 + (size_t)row * D;
#pragma unroll
            for (int j = 0; j < 8; ++j) { const f32x4 y = v[j] * rstd * gv[j] + bv[j]; *(f32x4*)(hr + 4 * lane + 256 * j) = y;
                u32x2 w; w.x = cvt_pk_bf16(y[0], y[1]); w.y = cvt_pk_bf16(y[2], y[3]); *(u32x2*)(br + 4 * lane + 256 * j) = w; }
        }
    }
}

DI void conv16(const bf16_t* P, int b, int t, int ch0, const float* cw, const float* cb, float (&o)[16]) {
    if (t < 0) {
#pragma unroll
        for (int e = 0; e < 16; ++e) o[e] = 0.f;
        return;
    }
#pragma unroll
    for (int q = 0; q < 4; ++q) { const f32x4 bq = *(const f32x4*)(cb + ch0 + 4 * q); o[4 * q] = bq[0]; o[4 * q + 1] = bq[1]; o[4 * q + 2] = bq[2]; o[4 * q + 3] = bq[3]; }
#pragma unroll
    for (int j = 0; j < 4; ++j) {
        const int tt = t - 3 + j;
        if (tt >= 0) {
            const bf16_t* xp = P + ((size_t)b * LT + tt) * NIN + C_X + ch0;
            const u32x4 x0 = *(const u32x4*)xp, x1 = *(const u32x4*)(xp + 8);
            float wp[16];
#pragma unroll
            for (int q = 0; q < 4; ++q) { const f32x4 wq = *(const f32x4*)(cw + j * 1536 + ch0 + 4 * q); wp[4 * q] = wq[0]; wp[4 * q + 1] = wq[1]; wp[4 * q + 2] = wq[2]; wp[4 * q + 3] = wq[3]; }
#pragma unroll
            for (int q = 0; q < 4; ++q) {
                o[2 * q] += wp[2 * q] * __uint_as_float(x0[q] << 16); o[2 * q + 1] += wp[2 * q + 1] * __uint_as_float(x0[q] & 0xffff0000u);
                o[8 + 2 * q] += wp[8 + 2 * q] * __uint_as_float(x1[q] << 16); o[8 + 2 * q + 1] += wp[8 + 2 * q + 1] * __uint_as_float(x1[q] & 0xffff0000u);
            }
        }
    }
#pragma unroll
    for (int e = 0; e < 16; ++e) o[e] = silu_f(o[e]);
}

DI void cumsum_item(LAS unsigned char* lds, const float* FDT, const float* bfg, float* CC, int bh) {
    int tid_ = threadIdx.x; asm volatile("" : "+v"(tid_));
    const int tid = tid_, wid = __builtin_amdgcn_readfirstlane(tid >> 6), lane = tid & 63;
    LAS float* wsum = (LAS float*)lds;
    const int b = bh >> 3, h = bh & 7; const float bias = bfg[h];
    float xv[9];
#pragma unroll
    for (int j = 0; j < 9; ++j) { const int t = tid * 9 + j; xv[j] = t < LT ? FDT[((size_t)b * LT + t) * 32 + h] + bias : 0.f; }
    float s = 0.f;
#pragma unroll
    for (int j = 0; j < 9; ++j) { const int t = tid * 9 + j; const float x = xv[j]; s += t < LT ? fminf(x, 0.f) - __logf(1.f + __expf(-fabsf(x))) : 0.f; xv[j] = s; }
    const float incl = wave_incl_scan(s, lane);
    __syncthreads();
    if (lane == 63) wsum[wid] = incl;
    __syncthreads();
    float off = incl - s;
    for (int w = 0; w < wid; ++w) off += wsum[w];
#pragma unroll
    for (int j = 0; j < 9; ++j) { const int t = tid * 9 + j; if (t < LT) CC[(size_t)bh * LT + t] = off + xv[j]; }
}

DI void chunk_dt(const float* FDT, const float* dt_bias, const float* a_log, int b, int t0, int h, int lane, float& dt0, float& dt1, float& ac0, float& ac1, float& total) {
    const int ta = t0 + 2 * lane, tb = ta + 1;
    const float bias = dt_bias[h], a = -__expf(a_log[h]);
    dt0 = ta >= 0 ? softplus_f(FDT[((size_t)b * LT + ta) * 32 + 8 + h] + bias) : 0.f;
    dt1 = tb >= 0 ? softplus_f(FDT[((size_t)b * LT + tb) * 32 + 8 + h] + bias) : 0.f;
    const float x0 = dt0 * a, x1 = dt1 * a, s = x0 + x1;
    const float incl = wave_incl_scan(s, lane), excl = incl - s;
    ac0 = excl + x0; ac1 = excl + s; total = __uint_as_float(__builtin_amdgcn_readlane(__float_as_uint(incl), 63));
}

DI void ssda_item(int it, LAS unsigned char* lds, const bf16_t* P, const float* FDT, const float* cw, const float* cb, const float* dt_bias, const float* a_log, float* ST, float* CD) {
    int tid_ = threadIdx.x; asm volatile("" : "+v"(tid_));
    const int tid = tid_, wid = __builtin_amdgcn_readfirstlane(tid >> 6), lane = tid & 63, fr = lane & 15, fq = lane >> 4;
    LAS bf16_t* xsT = (LAS bf16_t*)lds;
    LAS bf16_t* BmT = (LAS bf16_t*)(lds + 34816);
    LAS float* wl = (LAS float*)(lds + 69632);
    const int g = it & 1, rest = it >> 1, c = rest % NBLK, b = rest / NBLK, t0 = 128 * c - 112;
    { float dt0, dt1, ac0, ac1, total; chunk_dt(FDT, dt_bias, a_log, b, t0, g * 8 + wid, lane, dt0, dt1, ac0, ac1, total);
      wl[wid * 128 + 2 * lane] = dt0 * __expf(total - ac0); wl[wid * 128 + 2 * lane + 1] = dt1 * __expf(total - ac1);
      if (lane == 63) CD[(b * NBLK + c) * 16 + g * 8 + wid] = __expf(total); }
#pragma unroll
    for (int i = 0; i < 2; ++i) { const int l = (wid & 1) * 64 + lane, cg8 = (wid >> 1) + 4 * i; float o[16]; conv16(P, b, t0 + l, 1024 + g * 128 + cg8 * 16, cw, cb, o);
#pragma unroll
      for (int e = 0; e < 16; ++e) BmT[(cg8 * 16 + e) * 136 + l] = f2bf(o[e]); }
    __syncthreads();
    bf16x8 af[4];
#pragma unroll
    for (int ks = 0; ks < 4; ++ks) af[ks] = *(const LAS bf16x8*)(BmT + (16 * wid + fr) * 136 + ks * 32 + fq * 8);
    for (int h8 = 0; h8 < 8; ++h8) {
        const int h = g * 8 + h8;
        LAS bf16_t* xb = xsT + (h8 & 1) * (64 * 136);
        { const int l = (wid & 1) * 64 + lane, cg4 = wid >> 1; float o[16]; conv16(P, b, t0 + l, h * 64 + cg4 * 16, cw, cb, o); const float w = wl[h8 * 128 + l];
#pragma unroll
          for (int e = 0; e < 16; ++e) xb[(cg4 * 16 + e) * 136 + l] = f2bf(o[e] * w); }
        __syncthreads();
        float* stp = ST + ((size_t)((b * NBLK + c) * 16 + h)) * 8192;
#pragma unroll
        for (int mt = 0; mt < 4; ++mt) { f32x4 acc = (f32x4){0.f, 0.f, 0.f, 0.f};
#pragma unroll
            for (int ks = 0; ks < 4; ++ks) { const bf16x8 xf = *(const LAS bf16x8*)(xb + (16 * mt + fr) * 136 + ks * 32 + fq * 8); acc = mfma16(af[ks], xf, acc); }
            *(f32x4*)(stp + (16 * mt + fr) * 128 + 16 * wid + 4 * fq) = acc; }
    }
}

DI void scan_phase(float* ST, const float* CD) {
    int tid_ = threadIdx.x; asm volatile("" : "+v"(tid_));
    for (int e4 = blockIdx.x * NTHR + tid_; e4 < NBATCH * 16 * 64 * 32; e4 += gridDim.x * NTHR) {
        const int n4 = e4 & 31, pp = (e4 >> 5) & 63, h = (e4 >> 11) & 15, b = e4 >> 15;
        f32x4 hs = (f32x4){0.f, 0.f, 0.f, 0.f};
#pragma unroll 11
        for (int c = 0; c < NBLK; ++c) { f32x4* ptr = (f32x4*)(ST + ((size_t)((b * NBLK + c) * 16 + h)) * 8192 + pp * 128 + n4 * 4); const f32x4 s = *ptr; *ptr = hs; const float d = CD[(b * NBLK + c) * 16 + h]; hs = hs * d + s; }
    }
}

DI void ssdc_item(int it, LAS unsigned char* lds, const bf16_t* P, const float* FDT, const float* cw, const float* cb, const float* dt_bias, const float* a_log, const float* d_skip,
                   const float* norm_w, const float* ST, bf16_t* Y) {
    int tid_ = threadIdx.x; asm volatile("" : "+v"(tid_));
    const int tid = tid_, wid = __builtin_amdgcn_readfirstlane(tid >> 6), lane = tid & 63, fr = lane & 15, fq = lane >> 4;
    LAS bf16_t* BmS = (LAS bf16_t*)lds;
    LAS bf16_t* CmS = (LAS bf16_t*)(lds + 34816);
    LAS bf16_t* xsT = (LAS bf16_t*)(lds + 69632);
    LAS bf16_t* prevS = (LAS bf16_t*)(lds + 87040);
    LAS float* dts = (LAS float*)(lds + 104448);
    LAS float* acss = (LAS float*)(lds + 108544);
    {
        const int g = it & 1, rest = it >> 1, c = rest % NBLK, b = rest / NBLK, t0 = 128 * c - 112;
        { float dt0, dt1, ac0, ac1, total; chunk_dt(FDT, dt_bias, a_log, b, t0, g * 8 + wid, lane, dt0, dt1, ac0, ac1, total);
          dts[wid * 128 + 2 * lane] = dt0; dts[wid * 128 + 2 * lane + 1] = dt1; acss[wid * 128 + 2 * lane] = ac0; acss[wid * 128 + 2 * lane + 1] = ac1; }
#pragma unroll
        for (int i = 0; i < 4; ++i) { const int l = (wid & 1) * 64 + lane, cgi = (wid >> 1) + 4 * i; float o[16];
            conv16(P, b, t0 + l, (cgi < 8 ? 1024 : 1280) + g * 128 + (cgi & 7) * 16, cw, cb, o);
            LAS bf16_t* dst = (cgi < 8 ? BmS : CmS) + l * 136 + (cgi & 7) * 16;
            u32x4 w0, w1; w0.x = cvt_pk_bf16(o[0], o[1]); w0.y = cvt_pk_bf16(o[2], o[3]); w0.z = cvt_pk_bf16(o[4], o[5]); w0.w = cvt_pk_bf16(o[6], o[7]);
            w1.x = cvt_pk_bf16(o[8], o[9]); w1.y = cvt_pk_bf16(o[10], o[11]); w1.z = cvt_pk_bf16(o[12], o[13]); w1.w = cvt_pk_bf16(o[14], o[15]);
            *(LAS u32x4*)dst = w0; *(LAS u32x4*)(dst + 8) = w1; }
        __syncthreads();
        bf16x8 cmf[4];
#pragma unroll
        for (int ks = 0; ks < 4; ++ks) cmf[ks] = *(const LAS bf16x8*)(CmS + (16 * wid + fr) * 136 + ks * 32 + fq * 8);
        f32x4 cbt[8];
#pragma unroll
        for (int nt = 0; nt < 8; ++nt) { cbt[nt] = (f32x4){0.f, 0.f, 0.f, 0.f};
            if (nt <= wid) {
#pragma unroll
                for (int ks = 0; ks < 4; ++ks) { const bf16x8 bmf = *(const LAS bf16x8*)(BmS + (16 * nt + fr) * 136 + ks * 32 + fq * 8); cbt[nt] = mfma16(bmf, cmf[ks], cbt[nt]); } } }
        const int li = 16 * wid + fr, t = t0 + li; const bool valid = t >= 0;
        const size_t grow = (size_t)b * LT + (valid ? t : 0);
        float ssq = 0.f;
        for (int h8 = 0; h8 < 8; ++h8) {
            const int h = g * 8 + h8;
            __syncthreads();
            { const int l = (wid & 1) * 64 + lane, cg4 = wid >> 1; float o[16]; conv16(P, b, t0 + l, h * 64 + cg4 * 16, cw, cb, o);
#pragma unroll
              for (int e = 0; e < 16; ++e) xsT[(cg4 * 16 + e) * 136 + l] = f2bf(o[e]); }
            { const float* stp = ST + ((size_t)((b * NBLK + c) * 16 + h)) * 8192;
#pragma unroll
              for (int i = 0; i < 4; ++i) { const int idx = tid + NTHR * i, pp = idx >> 5, n4 = idx & 31; const f32x4 v = *(const f32x4*)(stp + pp * 128 + n4 * 4);
                  u32x2 w; w.x = cvt_pk_bf16(v[0], v[1]); w.y = cvt_pk_bf16(v[2], v[3]); *(LAS u32x2*)(prevS + pp * 136 + n4 * 4) = w; } }
            u32x2 zw4[4];
#pragma unroll
            for (int pt = 0; pt < 4; ++pt) zw4[pt] = *(const u32x2*)(P + grow * NIN + C_Z + h * 64 + 16 * pt + 4 * fq);
            __syncthreads();
            const float acl = acss[h8 * 128 + li];
            f32x4 yacc[4], yoff[4];
#pragma unroll
            for (int pt = 0; pt < 4; ++pt) { yacc[pt] = (f32x4){0.f, 0.f, 0.f, 0.f}; yoff[pt] = (f32x4){0.f, 0.f, 0.f, 0.f}; }
#pragma unroll
            for (int ksp = 0; ksp < 4; ++ksp) {
                if (2 * ksp <= wid) {
                    const int s0 = 32 * ksp + 4 * fq, s1 = s0 + 16;
                    const f32x4 as0 = *(const LAS f32x4*)(acss + h8 * 128 + s0), as1 = *(const LAS f32x4*)(acss + h8 * 128 + s1);
                    const f32x4 d0 = *(const LAS f32x4*)(dts + h8 * 128 + s0), d1 = *(const LAS f32x4*)(dts + h8 * 128 + s1);
                    float g0[4], g1[4];
#pragma unroll
                    for (int j = 0; j < 4; ++j) {
                        g0[j] = (s0 + j <= li) ? cbt[2 * ksp][j] * __expf(acl - as0[j]) * d0[j] : 0.f;
                        g1[j] = (s1 + j <= li) ? cbt[2 * ksp + 1][j] * __expf(acl - as1[j]) * d1[j] : 0.f;
                    }
                    u32x4 gw; gw.x = cvt_pk_bf16(g0[0], g0[1]); gw.y = cvt_pk_bf16(g0[2], g0[3]); gw.z = cvt_pk_bf16(g1[0], g1[1]); gw.w = cvt_pk_bf16(g1[2], g1[3]);
                    const bf16x8 gf = __builtin_bit_cast(bf16x8, gw);
#pragma unroll
                    for (int pt = 0; pt < 4; ++pt) {
                        const s16x4 lo = *(const LAS s16x4*)(xsT + (16 * pt + fr) * 136 + s0), hi = *(const LAS s16x4*)(xsT + (16 * pt + fr) * 136 + s1);
                        const bf16x8 xf = __builtin_shufflevector(lo, hi, 0, 1, 2, 3, 4, 5, 6, 7);
                        yacc[pt] = mfma16(xf, gf, yacc[pt]);
                    }
                }
            }
#pragma unroll
            for (int ks = 0; ks < 4; ++ks)
#pragma unroll
                for (int pt = 0; pt < 4; ++pt) { const bf16x8 pf = *(const LAS bf16x8*)(prevS + (16 * pt + fr) * 136 + ks * 32 + fq * 8); yoff[pt] = mfma16(pf, cmf[ks], yoff[pt]); }
            const float eal = __expf(acl), dsk = d_skip[h];
#pragma unroll
            for (int pt = 0; pt < 4; ++pt) {
                const int p0 = 16 * pt + 4 * fq;
                const u32x2 zw = zw4[pt];
                float zz[4] = {__uint_as_float(zw.x << 16), __uint_as_float(zw.x & 0xffff0000u), __uint_as_float(zw.y << 16), __uint_as_float(zw.y & 0xffff0000u)};
                float gy[4];
#pragma unroll
                for (int j = 0; j < 4; ++j) { const float xv = bf2f(xsT[(p0 + j) * 136 + li]); const float y = yacc[pt][j] + eal * yoff[pt][j] + xv * dsk; gy[j] = y * silu_f(zz[j]); ssq += gy[j] * gy[j]; }
                if (valid) { u32x2 w; w.x = cvt_pk_bf16(gy[0], gy[1]); w.y = cvt_pk_bf16(gy[2], gy[3]); *(u32x2*)(Y + grow * D + 1024 + h * 64 + p0) = w; }
            }
        }
        ssq += shx(ssq, 16, lane); ssq += shx(ssq, 32, lane);
        const float rstd = __builtin_amdgcn_rsqf(ssq * (1.f / 512.f) + RMS_EPS);
        if (valid) {
            u32x2 yv[8][4];
#pragma unroll
            for (int h8 = 0; h8 < 8; ++h8)
#pragma unroll
                for (int pt = 0; pt < 4; ++pt) yv[h8][pt] = *(const u32x2*)(Y + grow * D + 1024 + (g * 8 + h8) * 64 + 16 * pt + 4 * fq);
#pragma unroll
            for (int h8 = 0; h8 < 8; ++h8)
#pragma unroll
                for (int pt = 0; pt < 4; ++pt) { const int ch = (g * 8 + h8) * 64 + 16 * pt + 4 * fq; const u32x2 w = yv[h8][pt]; const f32x4 nw = *(const f32x4*)(norm_w + ch);
                    u32x2 o; o.x = cvt_pk_bf16(__uint_as_float(w.x << 16) * rstd * nw[0], __uint_as_float(w.x & 0xffff0000u) * rstd * nw[1]);
                    o.y = cvt_pk_bf16(__uint_as_float(w.y << 16) * rstd * nw[2], __uint_as_float(w.y & 0xffff0000u) * rstd * nw[3]); *(u32x2*)(Y + grow * D + 1024 + ch) = o; }
        }
    }
}

DI void pool_item(int it, LAS unsigned char* lds, const bf16_t* P, const bf16_t* PWT, const float* pscale, bf16_t* Y) {
    int tid_ = threadIdx.x; asm volatile("" : "+v"(tid_));
    const int tid = tid_, wid = __builtin_amdgcn_readfirstlane(tid >> 6), lane = tid & 63, fr = lane & 15, fq = lane >> 4;
    LAS bf16_t* Us = (LAS bf16_t*)lds;
    LAS bf16_t* Xs = (LAS bf16_t*)(lds + 36608);
    LAS bf16_t* Ws = (LAS bf16_t*)(lds + 36608 + 34816);
    {
        const int g = it & 3, rest = it >> 2, blk = rest % NBLK, b = rest / NBLK, t0 = 128 * blk - 112;
        for (int cidx = tid; cidx < 143 * 16; cidx += NTHR) { const int j = cidx >> 4, ch = cidx & 15, t = t0 - 15 + j;
            u32x4 v = (u32x4){0u, 0u, 0u, 0u}; if (t >= 0) v = *(const u32x4*)(P + ((size_t)b * LT + t) * NIN + C_U + g * 128 + ch * 8);
            *(LAS u32x4*)(Us + j * 128 + ch * 8) = v; }
        for (int cidx = tid; cidx < 128 * 16; cidx += NTHR) { const int d = cidx >> 4, ch = cidx & 15; *(LAS u32x4*)(Ws + d * 136 + ch * 8) = *(const u32x4*)(PWT + (size_t)(g * 128 + d) * 128 + ch * 8); }
        __syncthreads();
        { const int cch = tid & 127, w = 2 << g, i0 = (tid >> 7) * 32;
          float s = 0.f;
          for (int j = 1; j < w; ++j) s += bf2f(Us[(i0 + 15 - j) * 128 + cch]);
          for (int k = 0; k < 32; ++k) { const int i = i0 + k, t = t0 + i;
              const float ucur = bf2f(Us[(i + 15) * 128 + cch]); s += ucur;
              const int cnt = t + 1 < w ? (t + 1 < 1 ? 1 : t + 1) : w;
              Xs[i * 136 + cch] = f2bf(s / (float)cnt - ucur);
              s -= bf2f(Us[(i + 15 - (w - 1)) * 128 + cch]); } }
        __syncthreads();
        bf16x8 xf[4];
#pragma unroll
        for (int ks = 0; ks < 4; ++ks) xf[ks] = *(const LAS bf16x8*)(Xs + (16 * wid + fr) * 136 + ks * 32 + fq * 8);
        const int t = t0 + 16 * wid + fr;
#pragma unroll
        for (int nt = 0; nt < 8; ++nt) { f32x4 acc = (f32x4){0.f, 0.f, 0.f, 0.f};
#pragma unroll
            for (int ks = 0; ks < 4; ++ks) { const bf16x8 wf = *(const LAS bf16x8*)(Ws + (16 * nt + fr) * 136 + ks * 32 + fq * 8); acc = mfma16(wf, xf[ks], acc); }
            if (t >= 0) { const int d0 = 16 * nt + 4 * fq; const f32x4 sc = *(const f32x4*)(pscale + g * 128 + d0);
                u32x2 w; w.x = cvt_pk_bf16(acc[0] * sc[0], acc[1] * sc[1]); w.y = cvt_pk_bf16(acc[2] * sc[2], acc[3] * sc[3]);
                *(u32x2*)(Y + ((size_t)b * LT + t) * D + 512 + g * 128 + d0) = w; } }
    }
}

DI void attn_item(int it, LAS unsigned char* lds, const bf16_t* P, const float* CC, bf16_t* Y) {
    int tid_ = threadIdx.x; asm volatile("" : "+v"(tid_));
    const int tid = tid_, wid = __builtin_amdgcn_readfirstlane(tid >> 6), lane = tid & 63, fr = lane & 15, fq = lane >> 4;
    LAS bf16_t* Ks = (LAS bf16_t*)lds;
    LAS bf16_t* Vt = (LAS bf16_t*)(lds + 18432);
    LAS float* cks = (LAS float*)(lds + 18432 + 17408);
    {
        const int jp = 16 - (it >> 5), bh = it & 31;
        const int b = bh >> 3, h = bh & 7;
        const size_t rowb = (size_t)b * LT;
        const int qi = 16 * wid + fr;
        int qbs[2]; qbs[0] = 2 * jp; qbs[1] = 2 * jp + 1 <= 32 ? 2 * jp + 1 : -1;
        const int ktmax = qbs[1] >= 0 ? qbs[1] : qbs[0];
        bf16x8 qf[2][2]; float cq[2]; bool qvalid[2]; size_t qrow[2];
        f32x4 oacc[2][4]; float mrun[2], lsum[2];
#pragma unroll
        for (int qq = 0; qq < 2; ++qq) {
            const int tq = 128 * qbs[qq] - 112 + qi; qvalid[qq] = (qbs[qq] >= 0) && (tq >= 0);
            qrow[qq] = rowb + (qvalid[qq] ? tq : 0);
            const bf16_t* qp = P + qrow[qq] * NIN + C_Q + h * 64 + fq * 8;
#pragma unroll
            for (int ks = 0; ks < 2; ++ks) { const u32x4 qw = *(const u32x4*)(qp + 32 * ks); u32x4 qs;
#pragma unroll
                for (int e = 0; e < 4; ++e) qs[e] = cvt_pk_bf16(__uint_as_float(qw[e] << 16) * 0.125f, __uint_as_float(qw[e] & 0xffff0000u) * 0.125f);
                qf[qq][ks] = __builtin_bit_cast(bf16x8, qs); }
            cq[qq] = CC[(size_t)bh * LT + (qvalid[qq] ? tq : 0)];
#pragma unroll
            for (int mt = 0; mt < 4; ++mt) oacc[qq][mt] = (f32x4){0.f, 0.f, 0.f, 0.f};
            mrun[qq] = -1e30f; lsum[qq] = 0.f;
        }
        u32x4 kreg[2], vreg[2]; float creg = 0.f;
#define ATT_PREFETCH(kt_) do { const int tb_ = 128 * (kt_) - 112; \
        _Pragma("unroll") for (int i_ = 0; i_ < 2; ++i_) { const int c_ = tid + NTHR * i_; \
            { const int key_ = c_ >> 3, dch_ = c_ & 7, t_ = tb_ + key_; kreg[i_] = (u32x4){0u, 0u, 0u, 0u}; if (t_ >= 0) kreg[i_] = *(const u32x4*)(P + (rowb + t_) * NIN + C_K + h * 64 + dch_ * 8); } \
            { const int key_ = c_ >> 3, dch_ = c_ & 7, t_ = tb_ + key_; vreg[i_] = (u32x4){0u, 0u, 0u, 0u}; if (t_ >= 0) vreg[i_] = *(const u32x4*)(P + (rowb + t_) * NIN + C_V + h * 64 + dch_ * 8); } } \
        if (tid < 128) { const int t_ = tb_ + tid; creg = t_ >= 0 ? CC[(size_t)bh * LT + t_] : 0.f; } } while (0)
        ATT_PREFETCH(0);
        for (int kt = 0; kt <= ktmax; ++kt) {
            __syncthreads();
#pragma unroll
            for (int i = 0; i < 2; ++i) { const int cidx = tid + NTHR * i;
                { const int key = cidx >> 3, dch = cidx & 7; *(LAS u32x4*)(Ks + key * 72 + dch * 8) = kreg[i]; }
                { const int key = cidx >> 3, dch = cidx & 7, kx = key ^ (4 * dch);
#pragma unroll
                  for (int q = 0; q < 4; ++q) { Vt[(dch * 8 + 2 * q) * 136 + kx] = (bf16_t)(vreg[i][q] & 0xffffu); Vt[(dch * 8 + 2 * q + 1) * 136 + kx] = (bf16_t)(vreg[i][q] >> 16); } } }
            if (tid < 128) cks[tid] = creg;
            __syncthreads();
            if (kt < ktmax) ATT_PREFETCH(kt + 1);
            const bool act0 = kt <= qbs[0], act1 = kt <= qbs[1];
            f32x4 sc[2][8];
#pragma unroll
            for (int nt = 0; nt < 8; ++nt) { const f32x4 ck = *(const LAS f32x4*)(cks + 16 * nt + 4 * fq);
                const bf16x8 kf0 = *(const LAS bf16x8*)(Ks + (16 * nt + fr) * 72 + fq * 8), kf1 = *(const LAS bf16x8*)(Ks + (16 * nt + fr) * 72 + 32 + fq * 8);
                if (act0) { f32x4 s = cq[0] - ck; s = mfma16(kf0, qf[0][0], s); s = mfma16(kf1, qf[0][1], s); sc[0][nt] = s; }
                if (act1) { f32x4 s = cq[1] - ck; s = mfma16(kf0, qf[1][0], s); s = mfma16(kf1, qf[1][1], s); sc[1][nt] = s; } }
            bf16x8 pf[2][4];
#pragma unroll
            for (int qq = 0; qq < 2; ++qq) {
                if (qq == 0 ? act0 : act1) {
                    const int qb = qbs[qq];
                    if (kt == 0 || kt == qb) {
#pragma unroll
                        for (int nt = 0; nt < 8; ++nt)
#pragma unroll
                            for (int j = 0; j < 4; ++j) { const int sl = 16 * nt + 4 * fq + j; const bool ok = (kt > 0 || sl >= 112) && (kt < qb || sl <= qi); sc[qq][nt][j] = ok ? sc[qq][nt][j] : -1e30f; }
                    }
                    float mloc = -1e30f;
#pragma unroll
                    for (int nt = 0; nt < 8; ++nt) mloc = fmaxf(mloc, fmaxf(fmaxf(sc[qq][nt][0], sc[qq][nt][1]), fmaxf(sc[qq][nt][2], sc[qq][nt][3])));
                    mloc = fmaxf(mloc, shx(mloc, 16, lane)); mloc = fmaxf(mloc, shx(mloc, 32, lane));
                    const float mnew = fmaxf(mrun[qq], mloc), alpha = __builtin_amdgcn_exp2f((mrun[qq] - mnew) * LOG2E), mneg = -mnew * LOG2E; mrun[qq] = mnew;
                    float psum = 0.f;
#pragma unroll
                    for (int nt = 0; nt < 8; ++nt)
#pragma unroll
                        for (int j = 0; j < 4; ++j) { const float pv = __builtin_amdgcn_exp2f(__builtin_fmaf(sc[qq][nt][j], LOG2E, mneg)); sc[qq][nt][j] = pv; psum += pv; }
                    lsum[qq] = lsum[qq] * alpha + psum;
#pragma unroll
                    for (int mt = 0; mt < 4; ++mt) oacc[qq][mt] = oacc[qq][mt] * alpha;
#pragma unroll
                    for (int s4 = 0; s4 < 4; ++s4) {
                        u32x4 pw; pw.x = cvt_pk_bf16(sc[qq][2 * s4][0], sc[qq][2 * s4][1]); pw.y = cvt_pk_bf16(sc[qq][2 * s4][2], sc[qq][2 * s4][3]); pw.z = cvt_pk_bf16(sc[qq][2 * s4 + 1][0], sc[qq][2 * s4 + 1][1]); pw.w = cvt_pk_bf16(sc[qq][2 * s4 + 1][2], sc[qq][2 * s4 + 1][3]);
                        pf[qq][s4] = __builtin_bit_cast(bf16x8, pw); }
                }
            }
#pragma unroll
            for (int s4 = 0; s4 < 4; ++s4)
#pragma unroll
                for (int mt = 0; mt < 4; ++mt) {
                    const int vsw = 4 * (2 * mt + (fr >> 3));
                    const s16x4 lo = *(const LAS s16x4*)(Vt + (16 * mt + fr) * 136 + ((32 * s4 + 4 * fq) ^ vsw)), hi = *(const LAS s16x4*)(Vt + (16 * mt + fr) * 136 + ((32 * s4 + 16 + 4 * fq) ^ vsw));
                    const bf16x8 vf = __builtin_shufflevector(lo, hi, 0, 1, 2, 3, 4, 5, 6, 7);
                    if (act0) oacc[0][mt] = mfma16(vf, pf[0][s4], oacc[0][mt]);
                    if (act1) oacc[1][mt] = mfma16(vf, pf[1][s4], oacc[1][mt]);
                }
        }
#undef ATT_PREFETCH
#pragma unroll
        for (int qq = 0; qq < 2; ++qq) {
            float ls = lsum[qq]; ls += shx(ls, 16, lane); ls += shx(ls, 32, lane);
            const float inv = 1.f / ls;
            if (qvalid[qq]) {
#pragma unroll
                for (int mt = 0; mt < 4; ++mt) { u32x2 w; w.x = cvt_pk_bf16(oacc[qq][mt][0] * inv, oacc[qq][mt][1] * inv); w.y = cvt_pk_bf16(oacc[qq][mt][2] * inv, oacc[qq][mt][3] * inv);
                    *(u32x2*)(Y + qrow[qq] * D + h * 64 + 16 * mt + 4 * fq) = w; }
            }
        }
    }
}

#define XB_TMO      128
#define XB_XCNT(j)  (256  + 64 * (j))
#define XB_XSUB(j)  (1280 + 64 * (j))
#define XB_XGEN(j)  (2304 + 64 * (j))
#define XB_TOP      3328
#define XB_TOPGEN   3392
#define XB_SPIN_CAP (1u << 20)
DI unsigned xb_ld(unsigned* p)              { return __hip_atomic_load(p, __ATOMIC_RELAXED, __HIP_MEMORY_SCOPE_AGENT); }
DI unsigned xb_add(unsigned* p, unsigned v) { return __hip_atomic_fetch_add(p, v, __ATOMIC_RELAXED, __HIP_MEMORY_SCOPE_AGENT); }
DI unsigned xb_xcc_id() { return (unsigned)__builtin_amdgcn_s_getreg((3 << 11) | 20) & 0xFu; }
#define XB_SPIN(cond, bar) do { unsigned _sp = 0; while (cond) { __builtin_amdgcn_s_sleep(1); \
    if ((++_sp & 255u) == 0u) { if (xb_ld(&(bar)[XB_TMO])) break; if (_sp > XB_SPIN_CAP) { atomicAdd(&(bar)[XB_TMO], 1u); break; } } } } while (0)
struct XcdBarrier { unsigned* bar; unsigned x; volatile LAS unsigned* st; };
DI XcdBarrier xcd_barrier_post(unsigned* bar, volatile LAS unsigned* st) {
    XcdBarrier b; b.bar = bar; b.x = xb_xcc_id(); b.st = st;
    if (threadIdx.x == 0) (void)xb_add(&bar[XB_XCNT(b.x)], 1u);
    return b;
}
DI void xcd_barrier_complete(unsigned* bar, unsigned x, unsigned& nloc, unsigned& nx) {
    const unsigned G = gridDim.x * gridDim.y * gridDim.z;
    unsigned sum, cnt, mine, sp = 0u;
    for (;;) {
        sum = 0u; cnt = 0u; mine = 0u;
#pragma unroll
        for (unsigned j = 0; j < 16; ++j) { const unsigned c = xb_ld(&bar[XB_XCNT(j)]); sum += c; cnt += (c > 0u) ? 1u : 0u; mine = (j == x) ? c : mine; }
        if (sum == G) break;
        __builtin_amdgcn_s_sleep(1);
        if ((++sp & 255u) == 0u) { if (xb_ld(&bar[XB_TMO])) break; if (sp > XB_SPIN_CAP) { atomicAdd(&bar[XB_TMO], 1u); break; } }
    }
    nloc = mine > 0u ? mine : 1u; nx = cnt > 0u ? cnt : 1u;
}
DI void xcd_barrier(const XcdBarrier& b) {
    asm volatile("s_waitcnt vmcnt(0)" ::: "memory");
    __syncthreads();
    if (threadIdx.x == 0) {
        unsigned* bar = b.bar;
        __builtin_amdgcn_s_waitcnt(0);
        unsigned nloc = b.st[0], nx = b.st[1];
        if (nloc == 0u) { xcd_barrier_complete(bar, b.x, nloc, nx); b.st[0] = nloc; b.st[1] = nx; }
        const unsigned old = xb_add(&bar[XB_XSUB(b.x)], 1u);
        const unsigned gen = old / nloc;
        if (old + 1u == (gen + 1u) * nloc) {
            __builtin_amdgcn_fence(__ATOMIC_RELEASE, "agent");
            asm volatile("s_waitcnt vmcnt(0)" ::: "memory");
            const unsigned og = xb_add(&bar[XB_TOP], 1u);
            const unsigned tg = og / nx;
            if (og + 1u == (tg + 1u) * nx) xb_add(&bar[XB_TOPGEN], 1u);
            else XB_SPIN(xb_ld(&bar[XB_TOPGEN]) == tg, bar);
            __builtin_amdgcn_fence(__ATOMIC_ACQUIRE, "agent");
            xb_add(&bar[XB_XGEN(b.x)], 1u);
            asm volatile("s_waitcnt vmcnt(0)" ::: "memory");
        } else {
            XB_SPIN(xb_ld(&bar[XB_XGEN(b.x)]) == gen, bar);
            __builtin_amdgcn_fence(__ATOMIC_ACQUIRE, "agent");
            asm volatile("s_waitcnt vmcnt(0)" ::: "memory");
        }
    }
    __syncthreads();
}

constexpr int NSTEP_L = 9, NPHASE = 1 + NSTEP_L * DEPTH + 1;

__global__ void __launch_bounds__(NTHR) mega(Params p) {
    extern __shared__ __attribute__((aligned(16))) unsigned char lds_raw[];
    LAS unsigned char* lds = (LAS unsigned char*)lds_raw;
    cg::grid_group grid = cg::this_grid();
    LAS unsigned* stw = (LAS unsigned*)(lds + LDS_BYTES - 32);
    if (threadIdx.x == 0) { stw[0] = 0u; stw[1] = 0u; }
    __syncthreads();
    const XcdBarrier xb = xcd_barrier_post((unsigned*)(p.ws + WS_BAR), (volatile LAS unsigned*)stw);
    for (int ph = p.ph_lo; ph < p.ph_hi; ++ph) {
        if (p.ph_lo < 0) grid.sync();
        if (ph > p.ph_lo) xcd_barrier(xb);
        size_t zoff = 0; asm volatile("" : "+s"(zoff));
        unsigned char* ws = p.ws + zoff;
        float* H32 = (float*)(ws + WS_H32); bf16_t* H16 = (bf16_t*)(ws + WS_H16); float* ST = (float*)(ws + WS_H16);
        bf16_t* ACT = (bf16_t*)(ws + WS_BIG); bf16_t* PROJ = (bf16_t*)(ws + WS_BIG); bf16_t* Y = (bf16_t*)(ws + WS_BIG + SZ_PROJ);
        float* FDT = (float*)(ws + WS_FDT); float* CC = (float*)(ws + WS_CC); float* CD = (float*)(ws + WS_CD);
        float* STAT = (float*)(ws + WS_STAT);
        if (ph == 0) { prep_phase(lds, p); continue; }
        if (ph == NPHASE - 1) { ln_phase(H32, H16, p.in[23] + (DEPTH - 1) * D, p.in[24] + (DEPTH - 1) * D, p.out); continue; }
        const int l = (ph - 1) / NSTEP_L, s = (ph - 1) % NSTEP_L;
#ifdef REP_S
        for (int rep = 0; rep < ((s == REP_S) ? 2 : 1); ++rep) {
        if (rep) xcd_barrier(xb);
#else
        { const int rep = 0; (void)rep;
#endif
        switch (s) {
        case 0: case 7: {
            const int f = (s == 7), q = l * 2 + f, stg = 3 * l + 2 * f;
            const float* st = stg ? STAT + (size_t)stg * R * 2 : nullptr;
            const bf16_t* Wt = (const bf16_t*)(ws + WS_WGU + (size_t)q * SZ_WGU);
            const float* GW = (const float*)(ws + WS_GWGU) + (size_t)q * 2 * FF; const float* BW = (const float*)(ws + WS_BWGU) + (size_t)q * 2 * FF;
            pg8::Gemm g{H16, Wt, 2 * FF, D}; pg8::StaticOrder S; S.init(2 * FF, gridDim.x, blockIdx.x);
            pg8::EpiGU E{ACT, st, GW, BW};
            pg8::gemm_phase<pg8::EpiGU>(lds, g, S, E);
            skinny_phase<0>(lds, H16, D, Wt, FF / 16, ACT, nullptr, 0.f, st, GW, BW, nullptr, nullptr, nullptr, nullptr);
        } break;
        case 1: case 8: {
            const int f = (s == 8), q = l * 2 + f, stg = 3 * l + 2 * f;
            const float* st = stg ? STAT + (size_t)stg * R * 2 : nullptr;
            const float* lg = f ? p.in[18] + l * D : (l ? p.in[23] + (l - 1) * D : nullptr);
            const float* lb = f ? p.in[19] + l * D : (l ? p.in[24] + (l - 1) * D : nullptr);
            float* sto = STAT + (size_t)(stg + 1) * R * 2;
            const bf16_t* Wt = (const bf16_t*)(ws + WS_WDN + (size_t)q * SZ_WDN);
            pg8::Gemm g{ACT, Wt, D, FF}; pg8::StaticOrder S; S.init(D, gridDim.x, blockIdx.x);
            pg8::EpiRes<true> E{H32, H16, st, lg, lb, sto};
            pg8::gemm_phase<pg8::EpiRes<true>>(lds, g, S, E);
            skinny_phase<1>(lds, ACT, FF, Wt, D / 32, nullptr, H32, 0.5f, st, nullptr, nullptr, lg, lb, sto, H16);
        } break;
        case 2: {
            const float* st = STAT + (size_t)(3 * l + 1) * R * 2;
            const bf16_t* Wt = (const bf16_t*)(ws + WS_WIN + (size_t)l * SZ_WIN);
            const float* GW = (const float*)(ws + WS_GWIN) + (size_t)l * NIN; const float* BW = (const float*)(ws + WS_BWIN) + (size_t)l * NIN;
            pg8::Gemm g{H16, Wt, NIN, D}; pg8::StaticOrder S; S.init(NIN, gridDim.x, blockIdx.x);
            pg8::EpiWin E{PROJ, FDT, st, GW, BW};
            pg8::gemm_phase<pg8::EpiWin>(lds, g, S, E);
            skinny_phase<2>(lds, H16, D, Wt, NIN / 32, PROJ, FDT, 0.f, st, GW, BW, nullptr, nullptr, nullptr, nullptr);
        } break;
        case 3: {
            unsigned* ctr = (unsigned*)(ws + WS_Q) + ph + 32 * rep;
            LAS int* slot = (LAS int*)(lds + LDS_BYTES - 16);
            for (;;) {
                __syncthreads();
                if (threadIdx.x == 0) *slot = (int)atomicAdd(ctr, 1u);
                __syncthreads();
                const int it = *slot;
                constexpr int NSA = NBATCH * NBLK * 2, NPL = NBATCH * NBLK * 4;
                if (it >= NSA + NPL + 32) break;
                if (it < NSA) ssda_item(it, lds, PROJ, FDT, p.in[11] + l * 4 * 1536, p.in[12] + l * 1536, p.in[13] + l * 16, p.in[14] + l * 16, ST, CD);
                else if (it < NSA + NPL) pool_item(it - NSA, lds, PROJ, (const bf16_t*)(ws + WS_PWT) + (size_t)l * 4 * 128 * 128, p.in[10] + l * 512, Y);
                else cumsum_item(lds, FDT, p.in[8] + l * 8, CC, it - NSA - NPL);
            }
        } break;
        case 4:
            scan_phase(ST, CD);
            break;
        case 5: {
            unsigned* ctr = (unsigned*)(ws + WS_Q) + ph + 32 * rep;
            LAS int* slot = (LAS int*)(lds + LDS_BYTES - 16);
            for (;;) {
                __syncthreads();
                if (threadIdx.x == 0) *slot = (int)atomicAdd(ctr, 1u);
                __syncthreads();
                const int it = *slot;
                constexpr int NSC = NBATCH * NBLK * 2, NAT = 32 * 17;
                if (it >= NSC + NAT) break;
                if (it < NSC) ssdc_item(it, lds, PROJ, FDT, p.in[11] + l * 4 * 1536, p.in[12] + l * 1536, p.in[13] + l * 16, p.in[14] + l * 16, p.in[15] + l * 16, p.in[16] + l * 1024, ST, Y);
                else attn_item(it - NSC, lds, PROJ, CC, Y);
            }
        } break;
        case 6: {
            const float* st = STAT + (size_t)(3 * l + 1) * R * 2; float* sto = STAT + (size_t)(3 * l + 2) * R * 2;
            const bf16_t* Wt = (const bf16_t*)(ws + WS_WOUT + (size_t)l * SZ_WOUT);
            pg8::Gemm g{Y, Wt, D, D}; pg8::StaticOrder S; S.init(D, gridDim.x, blockIdx.x);
            pg8::EpiRes<false> E{H32, H16, st, p.in[5] + l * D, p.in[6] + l * D, sto};
            pg8::gemm_phase<pg8::EpiRes<false>>(lds, g, S, E);
            skinny_phase<1>(lds, Y, D, Wt, D / 32, nullptr, H32, 1.0f, st, nullptr, nullptr, p.in[5] + l * D, p.in[6] + l * D, sto, H16);
        } break;
        }
        }
    }
}

extern "C" void kernel_launch(void* const* d_in, const int* in_sizes, int n_in, void* d_out, int out_size, void* d_ws, size_t ws_size, hipStream_t stream) {
    static int grid = 0;
    if (grid == 0) {
        if (n_in != 25 || ws_size < WS_END) { fprintf(stderr, "kernel_launch: need 25 inputs and %zu bytes of workspace (got %d, %zu)\n", (size_t)WS_END, n_in, ws_size); grid = -1; return; }
        int dev = 0, cus = 0, per_cu = 0;
        (void)hipGetDevice(&dev);
        (void)hipDeviceGetAttribute(&cus, hipDeviceAttributeMultiprocessorCount, dev);
        if (hipFuncSetAttribute((const void*)mega, hipFuncAttributeMaxDynamicSharedMemorySize, LDS_BYTES) != hipSuccess) fprintf(stderr, "kernel_launch: hipFuncSetAttribute failed\n");
        if (hipOccupancyMaxActiveBlocksPerMultiprocessor(&per_cu, (const void*)mega, NTHR, LDS_BYTES) != hipSuccess || per_cu < 1) { fprintf(stderr, "kernel_launch: occupancy query says %d\n", per_cu); per_cu = 1; }
        (void)hipGetLastError();
        grid = cus * per_cu;
        if (grid != 256) { fprintf(stderr, "kernel_launch: this build's per-phase folded-LN tables assume a 256-workgroup grid (one per CU of a 256-CU device); got %d\n", grid); grid = -1; return; }
    }
    if (grid < 0) return;
    (void)hipMemsetAsync((unsigned char*)d_ws + WS_ZERO, 0, ZERO_BYTES, stream);
    Params p{};
    for (int i = 0; i < 25; ++i) p.in[i] = (const float*)d_in[i];
    p.out = (float*)d_out; p.ws = (unsigned char*)d_ws;
#if PER_PHASE_LAUNCH
    for (int ph = 0; ph < NPHASE; ++ph) { p.ph_lo = ph; p.ph_hi = ph + 1; hipLaunchKernelGGL(mega, dim3(grid), dim3(NTHR), LDS_BYTES, stream, p); }
#else
    p.ph_lo = 0; p.ph_hi = NPHASE;
    void* args[] = {&p};
    hipError_t e = hipLaunchCooperativeKernel((const void*)mega, dim3(grid), dim3(NTHR), args, LDS_BYTES, stream);
    if (e != hipSuccess) fprintf(stderr, "cooperative launch failed: %s (grid %d)\n", hipGetErrorString(e), grid);
#endif
}
```

```cpp
#include <hip/hip_runtime.h>
#include <hip/hip_cooperative_groups.h>
#include <cstdio>
namespace cg = cooperative_groups;

#ifndef PER_PHASE_LAUNCH
#define PER_PHASE_LAUNCH 0
#endif

#define LAS __attribute__((address_space(3)))
#define DI __device__ __forceinline__
typedef unsigned short bf16_t;
typedef short bf16x8 __attribute__((ext_vector_type(8)));
typedef short s16x4 __attribute__((ext_vector_type(4)));
typedef float f32x4 __attribute__((ext_vector_type(4)));
typedef unsigned u32x4 __attribute__((ext_vector_type(4)));
typedef unsigned u32x2 __attribute__((ext_vector_type(2)));

constexpr int D = 2048, NBATCH = 4, SEQ = 4096, NMETA = 16, LT = SEQ + NMETA  , R = NBATCH * LT  ;
constexpr int FF = 5632, NIN = 4864  , NBLK = 33, NTHR = 512, DEPTH = 2;
constexpr int C_Q = 0, C_K = 512, C_V = 1024, C_U = 1536, C_Z = 2048, C_X = 3072, C_F = 4608;
constexpr float ALPHA = 1.41421356237309515f, LN_EPS = 1e-5f, RMS_EPS = 1e-5f, LOG2E = 1.4426950408889634f;
constexpr int LDS_BYTES = 159744;

constexpr size_t SZ_WGU = (size_t)2 * FF * D * 2, SZ_WDN = (size_t)D * FF * 2, SZ_WIN = (size_t)NIN * D * 2, SZ_WOUT = (size_t)D * D * 2, SZ_PWT = (size_t)4 * 128 * 128 * 2;
constexpr size_t WS_WGU = 0;
constexpr size_t WS_WDN = WS_WGU + 4 * SZ_WGU;
constexpr size_t WS_WIN = WS_WDN + 4 * SZ_WDN;
constexpr size_t WS_WOUT = WS_WIN + 2 * SZ_WIN;
constexpr size_t WS_PWT = WS_WOUT + 2 * SZ_WOUT;
constexpr size_t WS_H32 = WS_PWT + 2 * SZ_PWT;
constexpr size_t WS_H16 = WS_H32 + (size_t)R * D * 4;
constexpr size_t SZ_ST = (size_t)NBATCH * NBLK * 16 * 64 * 128 * 4;
constexpr size_t WS_BIG = WS_H16 + SZ_ST;
constexpr size_t SZ_PROJ = (size_t)R * NIN * 2, SZ_Y = (size_t)R * D * 2;
constexpr size_t WS_FDT = WS_BIG + SZ_PROJ + SZ_Y;
constexpr size_t WS_CC = WS_FDT + (size_t)R * 32 * 4;
constexpr size_t WS_CD = WS_CC + (size_t)NBATCH * 8 * LT * 4;
constexpr size_t WS_ZERO = WS_CD + (size_t)NBATCH * NBLK * 16 * 4 + 256;
constexpr size_t WS_Q = WS_ZERO;
constexpr size_t WS_STAT = WS_Q + 256;
constexpr size_t WS_GWGU = WS_STAT + (size_t)7 * R * 2 * 4;
constexpr size_t WS_BWGU = WS_GWGU + (size_t)4 * 2 * FF * 4;
constexpr size_t WS_GWIN = WS_BWGU + (size_t)4 * 2 * FF * 4;
constexpr size_t WS_BWIN = WS_GWIN + (size_t)2 * NIN * 4;
constexpr size_t WS_BAR = WS_BWIN + (size_t)2 * NIN * 4;
constexpr size_t WS_END = WS_BAR + 3456 * 4 + 256 - (3456 * 4) % 256;
constexpr size_t ZERO_BYTES = WS_END - WS_ZERO;
static_assert((size_t)R * FF * 2 <= SZ_PROJ + SZ_Y, "ACT fits");
static_assert(SZ_ST >= (size_t)R * D * 2, "H16 fits");

typedef float f32x2c __attribute__((ext_vector_type(2)));
typedef __bf16 bf16x2c __attribute__((ext_vector_type(2)));
DI unsigned cvt_pk_bf16(float lo, float hi) { const f32x2c v = {lo, hi}; return __builtin_bit_cast(unsigned, __builtin_convertvector(v, bf16x2c)); }
DI float bf2f(bf16_t v) { return __uint_as_float(((unsigned)v) << 16); }
DI bf16_t f2bf(float f) { return (bf16_t)(cvt_pk_bf16(f, 0.f) & 0xffffu); }
DI float silu_f(float x) { return x * __builtin_amdgcn_rcpf(1.f + __expf(-x)); }
DI float softplus_f(float x) { return x > 20.f ? x : __logf(1.f + __expf(x)); }
DI float shx(float v, int mask, int lane) { return __uint_as_float((unsigned)__builtin_amdgcn_ds_bpermute((lane ^ mask) << 2, (int)__float_as_uint(v))); }
DI float wave_sum(float v, int lane) {
#pragma unroll
    for (int o = 1; o < 64; o <<= 1) v += shx(v, o, lane);
    return v;
}
DI float wave_incl_scan(float x, int lane) {
#pragma unroll
    for (int o = 1; o < 64; o <<= 1) { const float v = __uint_as_float((unsigned)__builtin_amdgcn_ds_bpermute((lane - o) << 2, (int)__float_as_uint(x))); if (lane >= o) x += v; }
    return x;
}
DI f32x4 mfma16(bf16x8 a, bf16x8 b, f32x4 c) { return __builtin_amdgcn_mfma_f32_16x16x32_bf16(a, b, c, 0, 0, 0); }
DI int memrow_meta(int r) { return (r >> 4) * LT + (r & 15); }
#define RLF(v, k) __uint_as_float(__builtin_amdgcn_readlane(__float_as_uint(v), (k)))
#define LDS_WAIT() asm volatile("s_waitcnt lgkmcnt(0)" ::: "memory")
typedef float f32x2 __attribute__((ext_vector_type(2)));
DI f32x2 row_stats(const float* st, size_t row) {
    float rstd = 1.f, mu = 0.f;
    if (st) { const f32x2 sq = *(const f32x2*)(st + row * 2); mu = sq.x * (1.f / D); const float var = fmaxf(sq.y * (1.f / D) - mu * mu, 0.f); rstd = __builtin_amdgcn_rsqf(var + LN_EPS); }
    return (f32x2){rstd, mu};
}

namespace pg8 {
constexpr int BM = 256, BK = 64, HALF = 128, HTB = HALF * BK * 2, NXCD = 8, WGM = 8;
DI int lds_byte(int r, int c) { const int st = (r >> 4) * 2 + (c >> 5), rr = r & 15, cc = c & 31, ob = rr * 64 + cc * 2; return st * 1024 + (ob ^ (((ob >> 9) & 1) << 5)); }
DI void stage_rc(int b, int& Rr, int& Cc) { const int st = b / 1024, sb = b % 1024, swz = sb ^ (((sb >> 9) & 1) << 5); Rr = (st >> 1) * 16 + swz / 64; Cc = (st & 1) * 32 + (swz % 64) / 2; }
DI int perm32(int rho) { const int n = rho >> 4, i = rho & 15; return 8 * (i >> 2) + 4 * n + (i & 3); }
struct Unit { int pm, pn; };
struct Gemm { const bf16_t* A; const bf16_t* Bt; int N, K; };
DI int rowbase(int pm) { return (pm >> 4) * LT + NMETA + (pm & 15) * 256; }
struct StaticOrder {
    int nM, nN, nwg, G, c;
    DI void init(int N, int G_, int c_) { nM = 64; nN = N / BM; nwg = nM * nN; G = G_; c = c_; }
    DI bool next(int i, Unit& u) const {
        const int L = __builtin_amdgcn_readfirstlane(i * G + c); if (L >= nwg) return false;
        int wgid = L; { const int q = nwg / NXCD, r = nwg % NXCD, xcd = wgid % NXCD, off = wgid / NXCD; wgid = (xcd < r ? xcd * (q + 1) : r * (q + 1) + (xcd - r) * q) + off; }
        const int nig = WGM * nN, gid = wgid / nig, fm = gid * WGM, gsz = (nM - fm) < WGM ? (nM - fm) : WGM;
        u.pm = fm + ((wgid % nig) % gsz); u.pn = (wgid % nig) / gsz; return true;
    }
};

constexpr int TAB_OFF = 131072, TABC_OFF = 131072 + 2048, TABC_BYTES = 2048, TAB_MAXU = 11;
struct EpiGU {
    static constexpr bool PERM = true, TAB = true; bf16_t* O; const float* ST; const float* GW; const float* BW;
    DI f32x2 row_fetch(int pm, int tid) const { const f32x2 rs = row_stats(ST, (size_t)(rowbase(pm) + (tid & 255))); return (f32x2){rs.x, rs.x * rs.y}; }
    DI float col_fetch(int pn, int tid) const { return tid < 256 ? GW[pn * 256 + tid] : BW[pn * 256 + tid - 256]; }
    DI void operator()(const f32x4 (&acc)[2][2][4][2], const Unit& u, int wr, int wc, int fr, int fq, const LAS unsigned char* tabR, const LAS unsigned char* tabC) const {
        asm volatile("" : "+v"(fr), "+v"(fq));
        const int row0 = rowbase(u.pm) + wr * 64 + fr, col0 = u.pn * 128 + wc * 32 + 8 * fq, lc0 = wc * 32 + 8 * fq;
        const LAS f32x2* tr = (const LAS f32x2*)tabR; const LAS float* tg = (const LAS float*)tabC; const LAS float* tb = (const LAS float*)(tabC + 1024);
        f32x4 gw[2][2], bw[2][2];
#pragma unroll
        for (int bj = 0; bj < 2; ++bj)
#pragma unroll
            for (int n = 0; n < 2; ++n) { gw[bj][n] = *(const LAS f32x4*)(tg + lc0 + bj * HALF + 4 * n); bw[bj][n] = *(const LAS f32x4*)(tb + lc0 + bj * HALF + 4 * n); }
#pragma unroll
        for (int ai = 0; ai < 2; ++ai)
#pragma unroll
            for (int m = 0; m < 4; ++m) {
                const size_t row = (size_t)(row0 + ai * HALF + m * 16);
                const f32x2 rs = tr[ai * HALF + wr * 64 + m * 16 + fr]; const float rstd = rs.x, rm = rs.y;
                bf16_t* rowp = O + row * FF + col0;
                const f32x4 g0 = acc[ai][0][m][0] * rstd - gw[0][0] * rm + bw[0][0], g1 = acc[ai][0][m][1] * rstd - gw[0][1] * rm + bw[0][1];
                const f32x4 u0 = acc[ai][1][m][0] * rstd - gw[1][0] * rm + bw[1][0], u1 = acc[ai][1][m][1] * rstd - gw[1][1] * rm + bw[1][1];
                const f32x4 t0 = g0 * (-LOG2E), t1 = g1 * (-LOG2E);
                f32x4 e0, e1;
#pragma unroll
                for (int j = 0; j < 4; ++j) { e0[j] = __builtin_amdgcn_exp2f(t0[j]); e1[j] = __builtin_amdgcn_exp2f(t1[j]); }
                e0 = e0 + 1.f; e1 = e1 + 1.f;
                f32x4 r0, r1;
#pragma unroll
                for (int j = 0; j < 4; ++j) { r0[j] = __builtin_amdgcn_rcpf(e0[j]); r1[j] = __builtin_amdgcn_rcpf(e1[j]); }
                const f32x4 v0 = (g0 * u0) * r0, v1 = (g1 * u1) * r1;
                u32x4 w; w.x = cvt_pk_bf16(v0[0], v0[1]); w.y = cvt_pk_bf16(v0[2], v0[3]); w.z = cvt_pk_bf16(v1[0], v1[1]); w.w = cvt_pk_bf16(v1[2], v1[3]);
                *(u32x4*)rowp = w;
            }
    }
};
template <bool HALFC> struct EpiRes {
    static constexpr bool PERM = false, TAB = false; static constexpr float coef = HALFC ? 0.5f : 1.0f; float* H; bf16_t* H16; const float* STin; const float* lg; const float* lb; float* STout;
    DI f32x2 row_fetch(int, int) const { return (f32x2){0.f, 0.f}; }
    DI float col_fetch(int, int) const { return 0.f; }
    DI void operator()(const f32x4 (&acc)[2][2][4][2], const Unit& u, int wr, int wc, int fr, int fq, const LAS unsigned char*, const LAS unsigned char*) const {
        asm volatile("" : "+v"(fr), "+v"(fq));
        const int row0 = rowbase(u.pm) + wr * 64 + fr, col0 = u.pn * BM + wc * 32 + 4 * fq;
        const bool has = STin != nullptr;
#pragma unroll
        for (int ai = 0; ai < 2; ++ai)
#pragma unroll
            for (int mp = 0; mp < 2; ++mp) {
                f32x4 hv[2][2][2]; f32x2 rsv2[2]; f32x4 gq[2][2], bq[2][2];
#pragma unroll
                for (int mm = 0; mm < 2; ++mm) { rsv2[mm] = row_stats(STin, (size_t)(row0 + ai * HALF + (2 * mp + mm) * 16));
                    const float* rowp = H + (size_t)(row0 + ai * HALF + (2 * mp + mm) * 16) * D + col0;
#pragma unroll
                    for (int bj = 0; bj < 2; ++bj)
#pragma unroll
                        for (int n = 0; n < 2; ++n) hv[mm][bj][n] = *(const f32x4*)(rowp + bj * HALF + n * 16); }
#pragma unroll
                for (int bj = 0; bj < 2; ++bj)
#pragma unroll
                    for (int n = 0; n < 2; ++n) {
                        gq[bj][n] = (f32x4){1.f, 1.f, 1.f, 1.f}; bq[bj][n] = (f32x4){0.f, 0.f, 0.f, 0.f};
                        if (has) { gq[bj][n] = *(const f32x4*)(lg + col0 + bj * HALF + n * 16); bq[bj][n] = *(const f32x4*)(lb + col0 + bj * HALF + n * 16); } }
#pragma unroll
                for (int mm = 0; mm < 2; ++mm) {
                    const int m = 2 * mp + mm;
                    const size_t row = (size_t)(row0 + ai * HALF + m * 16);
                    const float rstd = rsv2[mm].x, mu = rsv2[mm].y;
                    float* rowp = H + row * D + col0; bf16_t* row16 = H16 + row * D + col0;
                    float ps = 0.f, pq = 0.f;
#pragma unroll
                    for (int bj = 0; bj < 2; ++bj)
#pragma unroll
                        for (int n = 0; n < 2; ++n) {
                            const f32x4 h = (hv[mm][bj][n] - mu) * rstd * gq[bj][n] + bq[bj][n];
                            const f32x4 xn = h * ALPHA + acc[ai][bj][m][n] * coef;
                            *(f32x4*)(rowp + bj * HALF + n * 16) = xn;
                            u32x2 w; w.x = cvt_pk_bf16(xn[0], xn[1]); w.y = cvt_pk_bf16(xn[2], xn[3]); *(u32x2*)(row16 + bj * HALF + n * 16) = w;
                            ps += (xn[0] + xn[1]) + (xn[2] + xn[3]); pq += (xn[0] * xn[0] + xn[1] * xn[1]) + (xn[2] * xn[2] + xn[3] * xn[3]);
                        }
                    ps += shx(ps, 16, (fr + 16 * fq)); ps += shx(ps, 32, (fr + 16 * fq)); pq += shx(pq, 16, (fr + 16 * fq)); pq += shx(pq, 32, (fr + 16 * fq));
                    if (fq == 0) { unsafeAtomicAdd(STout + row * 2, ps); unsafeAtomicAdd(STout + row * 2 + 1, pq); }
                }
            }
    }
};
struct EpiWin {
    static constexpr bool PERM = true, TAB = true; bf16_t* P; float* FDT; const float* ST; const float* GW; const float* BW;
    DI f32x2 row_fetch(int pm, int tid) const { const f32x2 rs = row_stats(ST, (size_t)(rowbase(pm) + (tid & 255))); return (f32x2){rs.x, rs.x * rs.y}; }
    DI float col_fetch(int pn, int tid) const { return tid < 256 ? GW[pn * 256 + tid] : BW[pn * 256 + tid - 256]; }
    DI void operator()(const f32x4 (&acc)[2][2][4][2], const Unit& u, int wr, int wc, int fr, int fq, const LAS unsigned char* tabR, const LAS unsigned char* tabC) const {
        asm volatile("" : "+v"(fr), "+v"(fq));
        const int row0 = rowbase(u.pm) + wr * 64 + fr, col0 = u.pn * BM + wc * 32 + 8 * fq, lc0 = wc * 32 + 8 * fq;
        const LAS f32x2* tr = (const LAS f32x2*)tabR; const LAS float* tg = (const LAS float*)tabC; const LAS float* tb = (const LAS float*)(tabC + 1024);
        f32x4 gw[2][2], bw[2][2];
#pragma unroll
        for (int bj = 0; bj < 2; ++bj)
#pragma unroll
            for (int n = 0; n < 2; ++n) { gw[bj][n] = *(const LAS f32x4*)(tg + lc0 + bj * HALF + 4 * n); bw[bj][n] = *(const LAS f32x4*)(tb + lc0 + bj * HALF + 4 * n); }
#pragma unroll
        for (int ai = 0; ai < 2; ++ai)
#pragma unroll
            for (int m = 0; m < 4; ++m) {
                const size_t row = (size_t)(row0 + ai * HALF + m * 16);
                const f32x2 rs = tr[ai * HALF + wr * 64 + m * 16 + fr]; const float rstd = rs.x, rm = rs.y;
                bf16_t* rowp = P + row * NIN + col0;
                f32x4 v[2][2];
#pragma unroll
                for (int bj = 0; bj < 2; ++bj) {
                    v[bj][0] = acc[ai][bj][m][0] * rstd - gw[bj][0] * rm + bw[bj][0]; v[bj][1] = acc[ai][bj][m][1] * rstd - gw[bj][1] * rm + bw[bj][1];
                    u32x4 w; w.x = cvt_pk_bf16(v[bj][0][0], v[bj][0][1]); w.y = cvt_pk_bf16(v[bj][0][2], v[bj][0][3]); w.z = cvt_pk_bf16(v[bj][1][0], v[bj][1][1]); w.w = cvt_pk_bf16(v[bj][1][2], v[bj][1][3]);
                    *(u32x4*)(rowp + bj * HALF) = w;
                }
                if (u.pn == 18 && wc == 0 && fq < 3) { float* f = FDT + row * 32 + 8 * fq; *(f32x4*)f = v[0][0]; *(f32x4*)(f + 4) = v[0][1]; }
            }
    }
};

#ifndef PG8_SP2
#define PG8_SP2 true
#endif
#ifndef PG8_ALIGN
#define PG8_ALIGN true
#endif
template <class Epi, bool SP2 = PG8_SP2, bool ALIGN_EPI = PG8_ALIGN>
DI void gemm_phase(LAS unsigned char* lds, const Gemm g, const StaticOrder& S, const Epi& E) {
    int tid_ = threadIdx.x; asm volatile("" : "+v"(tid_));
    const int tid = tid_, wid = __builtin_amdgcn_readfirstlane(tid >> 6), lane = tid & 63, wr = wid >> 2, wc = wid & 3, fr = lane & 15, fq = lane >> 4;
    const int K = g.K, nt = K / BK;
    unsigned voffA[2], voffB[2];
#pragma unroll
    for (int i = 0; i < 2; ++i) { int Rr, Cc; stage_rc(tid * 16 + i * 8192, Rr, Cc); const int Rb = Epi::PERM ? ((Rr & ~31) + perm32(Rr & 31)) : Rr;
        voffA[i] = (unsigned)(Rr * K + Cc) * 2u; voffB[i] = (unsigned)(Rb * K + Cc) * 2u; }
    const size_t kstep = (size_t)(BK * 2);
    const size_t hstep = (size_t)HALF * K * 2;
    const size_t tstep = 2 * hstep;
    const size_t rstep = (size_t)K * 2;
    const unsigned ldsw = (unsigned)wid * 1024u;
    const int aoff = lds_byte(wr * 64 + fr, fq * 8), boff = lds_byte(wc * 32 + fr, fq * 8);
#define PG8_SA(b, h) (((b) * 2 + (h)) * HTB)
#define PG8_SB(b, h) ((4 + (b) * 2 + (h)) * HTB)
#define PG8_STAGE(bufoff, gbase, voff) do { _Pragma("unroll") for (int _i = 0; _i < 2; ++_i) \
        __builtin_amdgcn_global_load_lds((const unsigned*)((const char*)(gbase) + (voff)[_i]), (LAS unsigned*)(lds + (bufoff) + ldsw + _i * 8192), 16, 0, 0); } while (0)
#define PG8_LDA(dst, b, h) do { _Pragma("unroll") for (int m = 0; m < 4; ++m) _Pragma("unroll") for (int k = 0; k < 2; ++k) dst[m][k] = *(const LAS bf16x8*)(lds + PG8_SA(b, h) + aoff + m * 2048 + k * 1024); } while (0)
#define PG8_LDB(dst, b, h) do { _Pragma("unroll") for (int n = 0; n < 2; ++n) _Pragma("unroll") for (int k = 0; k < 2; ++k) dst[n][k] = *(const LAS bf16x8*)(lds + PG8_SB(b, h) + boff + n * 2048 + k * 1024); } while (0)
#define PG8_MMA(ai, bj, At, Bt) do { __builtin_amdgcn_s_setprio(1); _Pragma("unroll") for (int m = 0; m < 4; ++m) _Pragma("unroll") for (int n = 0; n < 2; ++n) _Pragma("unroll") for (int k = 0; k < 2; ++k) \
        acc[ai][bj][m][n] = __builtin_amdgcn_mfma_f32_16x16x32_bf16(Bt[n][k], At[m][k], acc[ai][bj][m][n], 0, 0, 0); __builtin_amdgcn_s_setprio(0); } while (0)
#define PG8_WAIT_V(n) asm volatile("s_waitcnt vmcnt(" #n ")" ::: "memory")
#define PG8_WAIT_L(n) asm volatile("s_waitcnt lgkmcnt(" #n ")" ::: "memory")
#define PG8_BAR __builtin_amdgcn_s_barrier()
#define PG8_SCHED __builtin_amdgcn_sched_barrier(0)
    Unit cur, nxt; int ui = 0;
    if (!S.next(0, cur)) return;
    f32x4 acc[2][2][4][2];
#pragma unroll
    for (int a = 0; a < 2; ++a)
#pragma unroll
        for (int b = 0; b < 2; ++b)
#pragma unroll
            for (int m = 0; m < 4; ++m)
#pragma unroll
                for (int n = 0; n < 2; ++n) acc[a][b][m][n] = (f32x4){0.f, 0.f, 0.f, 0.f};
    bf16x8 At[4][2], B0[2][2], B1[2][2];
    const char* cA = (const char*)g.A + (size_t)rowbase(cur.pm) * rstep; const char* cB = (const char*)g.Bt + (size_t)cur.pn * tstep;
    if (Epi::TAB) {
        const f32x2 rv = E.row_fetch(cur.pm, tid);
        float cv[TAB_MAXU];
#pragma unroll
        for (int i = 0; i < TAB_MAXU; ++i) { Unit uu; cv[i] = S.next(i, uu) ? E.col_fetch(uu.pn, tid) : 0.f; }
        if (tid < 256) *(LAS f32x2*)(lds + TAB_OFF + tid * 8) = rv;
#pragma unroll
        for (int i = 0; i < TAB_MAXU; ++i) *(LAS float*)(lds + TABC_OFF + i * TABC_BYTES + tid * 4) = cv[i];
        asm volatile("s_waitcnt vmcnt(0) lgkmcnt(0)" ::: "memory");
    }
    if constexpr (SP2) {
        PG8_STAGE(PG8_SB(0, 0), cB, voffB); PG8_STAGE(PG8_SB(0, 1), cB + hstep, voffB); PG8_STAGE(PG8_SA(0, 0), cA, voffA); PG8_STAGE(PG8_SA(0, 1), cA + hstep, voffA);
        if (wr == 1) PG8_BAR;
        PG8_WAIT_V(2); PG8_BAR;
        PG8_STAGE(PG8_SB(1, 0), cB + kstep, voffB); PG8_STAGE(PG8_SA(1, 0), cA + kstep, voffA); PG8_STAGE(PG8_SB(1, 1), cB + hstep + kstep, voffB);
        PG8_WAIT_V(6); PG8_BAR;
    } else {
    PG8_STAGE(PG8_SB(0, 0), cB, voffB); PG8_STAGE(PG8_SA(0, 0), cA, voffA); PG8_STAGE(PG8_SB(0, 1), cB + hstep, voffB); PG8_STAGE(PG8_SA(0, 1), cA + hstep, voffA);
    if (wr == 1) PG8_BAR;
    PG8_WAIT_V(4); PG8_BAR;
    PG8_STAGE(PG8_SB(1, 0), cB + kstep, voffB); PG8_STAGE(PG8_SA(1, 0), cA + kstep, voffA); PG8_STAGE(PG8_SB(1, 1), cB + hstep + kstep, voffB);
    PG8_WAIT_V(6); PG8_BAR;
    }
    for (;;) {
        const bool has_next = S.next(ui + 1, nxt);
        const char* nA = has_next ? (const char*)g.A + (size_t)rowbase(nxt.pm) * rstep : cA; const char* nB = has_next ? (const char*)g.Bt + (size_t)nxt.pn * tstep : cB;
        for (int t = 0; t < nt; t += 2) {
            const bool last = (t == nt - 2);
            const char* a1 = cA + (size_t)(t + 1) * kstep;
            const char* a2 = last ? nA : cA + (size_t)(t + 2) * kstep; const char* b2 = last ? nB : cB + (size_t)(t + 2) * kstep;
            const char* a3 = a2 + kstep; const char* b3 = b2 + kstep;
            if constexpr (SP2) {
            PG8_LDB(B0, 0, 0); PG8_LDB(B1, 0, 1); PG8_SCHED; PG8_LDA(At, 0, 0); PG8_STAGE(PG8_SA(1, 1), a1 + hstep, voffA);
            PG8_WAIT_V(8); PG8_WAIT_L(0); PG8_BAR; PG8_MMA(0, 0, At, B0); PG8_MMA(0, 1, At, B1); PG8_BAR; PG8_SCHED;
            PG8_LDA(At, 0, 1); PG8_STAGE(PG8_SB(0, 0), b2, voffB); PG8_STAGE(PG8_SB(0, 1), b2 + hstep, voffB); PG8_STAGE(PG8_SA(0, 0), a2, voffA);
            PG8_WAIT_V(8); PG8_WAIT_L(0); PG8_BAR; PG8_MMA(1, 0, At, B0); PG8_MMA(1, 1, At, B1); PG8_BAR; PG8_SCHED;
            PG8_LDB(B0, 1, 0); PG8_LDB(B1, 1, 1); PG8_SCHED; PG8_LDA(At, 1, 0); PG8_STAGE(PG8_SA(0, 1), a2 + hstep, voffA);
            PG8_WAIT_V(8); PG8_WAIT_L(0); PG8_BAR; PG8_MMA(0, 0, At, B0); PG8_MMA(0, 1, At, B1); PG8_BAR; PG8_SCHED;
            PG8_LDA(At, 1, 1); PG8_STAGE(PG8_SB(1, 0), b3, voffB); PG8_STAGE(PG8_SB(1, 1), b3 + hstep, voffB); PG8_STAGE(PG8_SA(1, 0), a3, voffA);
            PG8_WAIT_V(8); PG8_WAIT_L(0); PG8_BAR; PG8_MMA(1, 0, At, B0); PG8_MMA(1, 1, At, B1); PG8_BAR; PG8_SCHED;
            } else {
            PG8_LDB(B0, 0, 0); PG8_SCHED; PG8_LDA(At, 0, 0); PG8_STAGE(PG8_SA(1, 1), a1 + hstep, voffA);
            PG8_WAIT_L(8); PG8_BAR; PG8_WAIT_L(0); PG8_MMA(0, 0, At, B0); PG8_BAR; PG8_SCHED;
            PG8_LDB(B1, 0, 1); PG8_STAGE(PG8_SB(0, 0), b2, voffB);
            PG8_BAR; PG8_WAIT_L(0); PG8_MMA(0, 1, At, B1); PG8_BAR;
            PG8_LDA(At, 0, 1); PG8_STAGE(PG8_SA(0, 0), a2, voffA);
            PG8_BAR; PG8_WAIT_L(0); PG8_MMA(1, 0, At, B0); PG8_BAR; PG8_SCHED;
            PG8_STAGE(PG8_SB(0, 1), b2 + hstep, voffB);
            PG8_WAIT_V(6); PG8_BAR; PG8_MMA(1, 1, At, B1); PG8_BAR;
            PG8_LDB(B0, 1, 0); PG8_SCHED; PG8_LDA(At, 1, 0); PG8_STAGE(PG8_SA(0, 1), a2 + hstep, voffA);
            PG8_WAIT_L(8); PG8_BAR; PG8_WAIT_L(0); PG8_MMA(0, 0, At, B0); PG8_BAR; PG8_SCHED;
            PG8_LDB(B1, 1, 1); PG8_STAGE(PG8_SB(1, 0), b3, voffB);
            PG8_BAR; PG8_WAIT_L(0); PG8_MMA(0, 1, At, B1); PG8_BAR;
            PG8_LDA(At, 1, 1); PG8_STAGE(PG8_SA(1, 0), a3, voffA);
            PG8_BAR; PG8_WAIT_L(0); PG8_MMA(1, 0, At, B0); PG8_BAR; PG8_SCHED;
            PG8_STAGE(PG8_SB(1, 1), b3 + hstep, voffB);
            PG8_WAIT_V(6); PG8_BAR; PG8_MMA(1, 1, At, B1); PG8_BAR;
            }
        }
        if constexpr (ALIGN_EPI) { if (wr == 0) PG8_BAR; }
        E(acc, cur, wr, wc, fr, fq, lds + TAB_OFF, lds + TABC_OFF + (ui < TAB_MAXU ? ui : TAB_MAXU - 1) * TABC_BYTES);
        if (!has_next) break;
#pragma unroll
        for (int a = 0; a < 2; ++a)
#pragma unroll
            for (int b = 0; b < 2; ++b)
#pragma unroll
                for (int m = 0; m < 4; ++m)
#pragma unroll
                    for (int n = 0; n < 2; ++n) acc[a][b][m][n] = (f32x4){0.f, 0.f, 0.f, 0.f};
        cur = nxt; cA = nA; cB = nB; ++ui;
        if constexpr (ALIGN_EPI) { if (wr == 1) PG8_BAR; }
    }
    PG8_WAIT_V(0);
    if constexpr (!ALIGN_EPI) { if (wr == 0) PG8_BAR; }
    PG8_BAR;
#undef PG8_SA
#undef PG8_SB
#undef PG8_STAGE
#undef PG8_LDA
#undef PG8_LDB
#undef PG8_MMA
#undef PG8_WAIT_V
#undef PG8_WAIT_L
#undef PG8_BAR
#undef PG8_SCHED
}
}

template <int KIND>
DI void skinny_phase(LAS unsigned char* lds, const bf16_t* A, int K, const bf16_t* Wt, int nunits, bf16_t* O16, float* O32, float coef,
                     const float* STin, const float* GW, const float* BW, const float* lg, const float* lb, float* STout, bf16_t* H16o) {
    int tid_ = threadIdx.x; asm volatile("" : "+v"(tid_));
    const int tid = tid_, wid = __builtin_amdgcn_readfirstlane(tid >> 6), lane = tid & 63, fr = lane & 15, fq = lane >> 4;
    LAS float* red = (LAS float*)lds;
    LAS float* red2 = (LAS float*)(lds + 16384);
    const int kper = (K / 32) / 8, ks0 = wid * kper, ks1 = ks0 + kper;
    const bf16x8 zero8 = (bf16x8){0, 0, 0, 0, 0, 0, 0, 0};
    for (int u = blockIdx.x; u < nunits; u += gridDim.x) {
        int r0, r1;
        if (KIND == 0) { const int j0 = 16 * u; r0 = (j0 >> 7) * 256 + (j0 & 127); r1 = r0 + 128; } else { r0 = 32 * u; r1 = r0 + 16; }
        f32x4 acc0 = (f32x4){0.f, 0.f, 0.f, 0.f}, acc1 = (f32x4){0.f, 0.f, 0.f, 0.f};
        const bf16_t* a0 = A + (size_t)fr * K + fq * 8;
        const bf16_t* b0 = Wt + (size_t)(r0 + fr) * K + fq * 8;
        const bf16_t* b1 = Wt + (size_t)(r1 + fr) * K + fq * 8;
        bf16x8 ca[4], cb0[4], cb1[4];
#pragma unroll
        for (int s = 0; s < 4; ++s) { const bool ok = ks0 + s < ks1; const int k = (ks0 + s) * 32; ca[s] = zero8; cb0[s] = zero8; cb1[s] = zero8;
            if (ok) { ca[s] = *(const bf16x8*)(a0 + k); cb0[s] = *(const bf16x8*)(b0 + k); cb1[s] = *(const bf16x8*)(b1 + k); } }
        for (int ks = ks0; ks < ks1; ks += 4) {
            bf16x8 na[4], nb0[4], nb1[4];
#pragma unroll
            for (int s = 0; s < 4; ++s) { const bool ok = ks + 4 + s < ks1; const int k = (ks + 4 + s) * 32; na[s] = zero8; nb0[s] = zero8; nb1[s] = zero8;
                if (ok) { na[s] = *(const bf16x8*)(a0 + k); nb0[s] = *(const bf16x8*)(b0 + k); nb1[s] = *(const bf16x8*)(b1 + k); } }
#pragma unroll
            for (int s = 0; s < 4; ++s) { acc0 = mfma16(ca[s], cb0[s], acc0); acc1 = mfma16(ca[s], cb1[s], acc1); }
#pragma unroll
            for (int s = 0; s < 4; ++s) { ca[s] = na[s]; cb0[s] = nb0[s]; cb1[s] = nb1[s]; }
        }
#pragma unroll
        for (int j = 0; j < 4; ++j) { red[(wid * 16 + 4 * fq + j) * 32 + fr] = acc0[j]; red[(wid * 16 + 4 * fq + j) * 32 + 16 + fr] = acc1[j]; }
        __syncthreads();
        { float s = 0.f;
#pragma unroll
          for (int w = 0; w < 8; ++w) s += red[w * 512 + tid];
          red2[tid] = s; }
        __syncthreads();
        const int r = tid >> 5, c = tid & 31;
        const f32x2 rs_ = row_stats(STin, (size_t)r); const float rstd = rs_.x, mu = rs_.y;
        if (KIND == 0) {
            if (c < 16) { const float rm = rstd * mu;
                const float gv = red2[r * 32 + c] * rstd - rm * GW[r0 + c] + BW[r0 + c], uv = red2[r * 32 + 16 + c] * rstd - rm * GW[r1 + c] + BW[r1 + c];
                const bf16_t o = f2bf(silu_f(gv) * uv);
#pragma unroll
                for (int bb = 0; bb < NBATCH; ++bb) O16[((size_t)bb * LT + r) * FF + 16 * u + c] = o; }
        } else if (KIND == 1) {
            const int col = 32 * u + c;
            float h = O32[(size_t)r * D + col]; if (STin) h = (h - mu) * rstd * lg[col] + lb[col];
            const float xn = h * ALPHA + red2[tid] * coef; const bf16_t xb = f2bf(xn);
            float ps = xn, pq = xn * xn;
#pragma unroll
            for (int o = 1; o < 32; o <<= 1) { ps += shx(ps, o, lane); pq += shx(pq, o, lane); }
#pragma unroll
            for (int bb = 0; bb < NBATCH; ++bb) { const size_t row = (size_t)bb * LT + r; O32[row * D + col] = xn; H16o[row * D + col] = xb;
                if (c == 0) { unsafeAtomicAdd(STout + row * 2, ps); unsafeAtomicAdd(STout + row * 2 + 1, pq); } }
        } else {
            const int col = 32 * u + c; const float v = red2[tid] * rstd - rstd * mu * GW[col] + BW[col]; const bf16_t vb = f2bf(v);
#pragma unroll
            for (int bb = 0; bb < NBATCH; ++bb) { const size_t row = (size_t)bb * LT + r; O16[row * NIN + col] = vb;
                if (col >= C_F && col < C_F + 24) O32[row * 32 + col - C_F] = v; }
        }
        __syncthreads();
    }
}

DI void transpose_item(const float* W, int N, int k0, int sc, bf16_t* dst, int K, LAS float* scr, int lane, const float* gvec = nullptr, const float* bvec = nullptr, float* GWp = nullptr, float* BWp = nullptr) {
    float tv[32];
#pragma unroll
    for (int i = 0; i < 32; ++i) { const int kk = 2 * i + (lane >> 5); tv[i] = sc >= 0 ? W[(size_t)(k0 + kk) * N + sc] : 0.f; }
    if (gvec) {
        const float gl = gvec[k0 + lane], bl = bvec[k0 + lane]; float sg = 0.f, sb = 0.f; const bool hi = lane >= 32;
#pragma unroll
        for (int i = 0; i < 32; ++i) {
            const float g0 = RLF(gl, 2 * i), g1 = RLF(gl, 2 * i + 1), b0 = RLF(bl, 2 * i), b1 = RLF(bl, 2 * i + 1);
            sb += tv[i] * (hi ? b1 : b0); tv[i] *= (hi ? g1 : g0); sg += tv[i]; }
        sg += shx(sg, 32, lane); sb += shx(sb, 32, lane);
        if (lane < 32 && sc >= 0) { unsafeAtomicAdd(GWp + lane, sg); unsafeAtomicAdd(BWp + lane, sb); }
    }
#pragma unroll
    for (int i = 0; i < 32; ++i) { const int kk = 2 * i + (lane >> 5); scr[kk * 33 + (lane & 31)] = tv[i]; }
    LDS_WAIT();
    const int c = lane & 7;
#pragma unroll
    for (int j = 0; j < 4; ++j) { const int n = (lane >> 3) + 8 * j; const LAS float* s = scr + (8 * c) * 33 + n;
        u32x4 o; o.x = cvt_pk_bf16(s[0 * 33], s[1 * 33]); o.y = cvt_pk_bf16(s[2 * 33], s[3 * 33]); o.z = cvt_pk_bf16(s[4 * 33], s[5 * 33]); o.w = cvt_pk_bf16(s[6 * 33], s[7 * 33]);
        *(u32x4*)(dst + (size_t)n * K + 8 * c) = o; }
    LDS_WAIT();
}

struct Params { const float* in[25]; float* out; unsigned char* ws; int ph_lo, ph_hi; };

DI void prep_phase(LAS unsigned char* lds, const Params& p) {
    int tid_ = threadIdx.x; asm volatile("" : "+v"(tid_));
    const int tid = tid_, wid = __builtin_amdgcn_readfirstlane(tid >> 6), lane = tid & 63;
    LAS float* scr = (LAS float*)(lds + wid * 8448);
    const int gw = blockIdx.x * 8 + wid, NGW = gridDim.x * 8;
    constexpr int I_GU = 32 * 176, I_DN = 88 * 64, I_IN = 32 * 145, I_OUT = 32 * 64, I_PW = 8;
    constexpr int S0 = 8 * I_GU, S1 = S0 + 4 * I_DN, S2 = S1 + 2 * I_IN, S3 = S2 + 2 * I_OUT, S4 = S3 + 8 * I_PW;
    unsigned char* ws = p.ws;
    for (int it = gw; it < S4; it += NGW) {
        if (it < S0) {
            const int mi = it / I_GU, r = it % I_GU, q = mi >> 1, part = mi & 1, l = q >> 1, f = q & 1;
            const float* W = p.in[(f ? 20 : 2) + part] + (size_t)l * D * FF;
            const int kb = r / 176, nb = r % 176, n0 = 32 * nb;
            bf16_t* WT = (bf16_t*)(ws + WS_WGU + (size_t)q * SZ_WGU);
            const int drow = (n0 >> 7) * 256 + (n0 & 127) + part * 128;
            const float* gvec = f ? p.in[18] + l * D : (l ? p.in[23] + (l - 1) * D : nullptr);
            const float* bvec = f ? p.in[19] + l * D : (l ? p.in[24] + (l - 1) * D : nullptr);
            transpose_item(W, FF, 64 * kb, n0 + (lane & 31), WT + (size_t)drow * D + 64 * kb, D, scr, lane, gvec, bvec,
                           (float*)(ws + WS_GWGU) + (size_t)q * 2 * FF + drow, (float*)(ws + WS_BWGU) + (size_t)q * 2 * FF + drow);
        } else if (it < S1) {
            const int j = it - S0, q = j / I_DN, r = j % I_DN, l = q >> 1, f = q & 1;
            const float* W = p.in[f ? 22 : 4] + (size_t)l * FF * D;
            const int kb = r / 64, nb = r % 64;
            bf16_t* WT = (bf16_t*)(ws + WS_WDN + (size_t)q * SZ_WDN);
            transpose_item(W, D, 64 * kb, 32 * nb + (lane & 31), WT + (size_t)(32 * nb) * FF + 64 * kb, FF, scr, lane);
        } else if (it < S2) {
            const int j = it - S1, l = j / I_IN, r = j % I_IN;
            const float* W = p.in[7] + (size_t)l * D * 4632;
            const int kb = r / 145, nb = r % 145, dn = 32 * nb + (lane & 31);
            int sc;
            if (dn < 1536) sc = dn; else if (dn < 4608) sc = dn + 8; else if (dn < 4616) sc = 1536 + (dn - 4608); else if (dn < 4632) sc = dn; else sc = -1;
            bf16_t* WT = (bf16_t*)(ws + WS_WIN + (size_t)l * SZ_WIN);
            transpose_item(W, 4632, 64 * kb, sc, WT + (size_t)(32 * nb) * D + 64 * kb, D, scr, lane, p.in[5] + l * D, p.in[6] + l * D,
                           (float*)(ws + WS_GWIN) + (size_t)l * NIN + 32 * nb, (float*)(ws + WS_BWIN) + (size_t)l * NIN + 32 * nb);
        } else if (it < S3) {
            const int j = it - S2, l = j / I_OUT, r = j % I_OUT;
            const float* W = p.in[17] + (size_t)l * D * D;
            const int kb = r / 64, nb = r % 64;
            bf16_t* WT = (bf16_t*)(ws + WS_WOUT + (size_t)l * SZ_WOUT);
            transpose_item(W, D, 64 * kb, 32 * nb + (lane & 31), WT + (size_t)(32 * nb) * D + 64 * kb, D, scr, lane);
        } else {
            const int j = it - S3, lg = j / I_PW, r = j % I_PW;
            const float* W = p.in[9] + (size_t)lg * 128 * 128;
            const int kb = r / 4, nb = r % 4;
            bf16_t* WT = (bf16_t*)(ws + WS_PWT) + (size_t)lg * 128 * 128;
            transpose_item(W, 128, 64 * kb, 32 * nb + (lane & 31), WT + (size_t)(32 * nb) * 128 + 64 * kb, 128, scr, lane);
        }
    }
    float* H32 = (float*)(ws + WS_H32); bf16_t* H16 = (bf16_t*)(ws + WS_H16);
    for (int row = gw; row < R; row += NGW) {
        const int b = row / LT, t = row % LT;
        const float* src = t < NMETA ? p.in[1] + (size_t)t * D : p.in[0] + ((size_t)b * SEQ + (t - NMETA)) * D;
#pragma unroll
        for (int j = 0; j < 8; ++j) { const int col = 4 * lane + 256 * j; const f32x4 v = *(const f32x4*)(src + col);
            *(f32x4*)(H32 + (size_t)row * D + col) = v; u32x2 w; w.x = cvt_pk_bf16(v[0], v[1]); w.y = cvt_pk_bf16(v[2], v[3]); *(u32x2*)(H16 + (size_t)row * D + col) = w; }
    }
}

DI void ln_phase(float* H32, bf16_t* H16, const float* g, const float* bta, float* out) {
    int tid_ = threadIdx.x; asm volatile("" : "+v"(tid_));
    const int tid = tid_, wid = __builtin_amdgcn_readfirstlane(tid >> 6), lane = tid & 63;
    const int gw = blockIdx.x * 8 + wid, NGW = gridDim.x * 8;
    f32x4 gv[8], bv[8];
#pragma unroll
    for (int j = 0; j < 8; ++j) { gv[j] = *(const f32x4*)(g + 4 * lane + 256 * j); bv[j] = *(const f32x4*)(bta + 4 * lane + 256 * j); }
    for (int row = gw; row < R; row += NGW) {
        float* hr = H32 + (size_t)row * D;
        f32x4 v[8]; float s = 0.f;
#pragma unroll
        for (int j = 0; j < 8; ++j) { v[j] = *(const f32x4*)(hr + 4 * lane + 256 * j); s += (v[j][0] + v[j][1]) + (v[j][2] + v[j][3]); }
        const float mean = wave_sum(s, lane) * (1.f / D); float s2 = 0.f;
#pragma unroll
        for (int j = 0; j < 8; ++j) { v[j] = v[j] - mean; s2 += (v[j][0] * v[j][0] + v[j][1] * v[j][1]) + (v[j][2] * v[j][2] + v[j][3] * v[j][3]); }
        const float rstd = __builtin_amdgcn_rsqf(wave_sum(s2, lane) * (1.f / D) + LN_EPS);
        if (out) {
            const int b = row / LT, t = row % LT;
            if (t >= NMETA) { float* orow = out + ((size_t)b * SEQ + (t - NMETA)) * D;
#pragma unroll
                for (int j = 0; j < 8; ++j) *(f32x4*)(orow + 4 * lane + 256 * j) = v[j] * rstd * gv[j] + bv[j]; }
        } else {
            bf16_t* br = H16 + (size_t)row * D;
#pragma unroll
            for (int j = 0; j < 8; ++j) { const f32x4 y = v[j] * rstd * gv[j] + bv[j]; *(f32x4*)(hr + 4 * lane + 256 * j) = y;
                u32x2 w; w.x = cvt_pk_bf16(y[0], y[1]); w.y = cvt_pk_bf16(y[2], y[3]); *(u32x2*)(br + 4 * lane + 256 * j) = w; }
        }
    }
}

DI void conv16(const bf16_t* P, int b, int t, int ch0, const float* cw, const float* cb, float (&o)[16]) {
    if (t < 0) {
#pragma unroll
        for (int e = 0; e < 16; ++e) o[e] = 0.f;
        return;
    }
#pragma unroll
    for (int q = 0; q < 4; ++q) { const f32x4 bq = *(const f32x4*)(cb + ch0 + 4 * q); o[4 * q] = bq[0]; o[4 * q + 1] = bq[1]; o[4 * q + 2] = bq[2]; o[4 * q + 3] = bq[3]; }
#pragma unroll
    for (int j = 0; j < 4; ++j) {
        const int tt = t - 3 + j;
        if (tt >= 0) {
            const bf16_t* xp = P + ((size_t)b * LT + tt) * NIN + C_X + ch0;
            const u32x4 x0 = *(const u32x4*)xp, x1 = *(const u32x4*)(xp + 8);
            float wp[16];
#pragma unroll
            for (int q = 0; q < 4; ++q) { const f32x4 wq = *(const f32x4*)(cw + j * 1536 + ch0 + 4 * q); wp[4 * q] = wq[0]; wp[4 * q + 1] = wq[1]; wp[4 * q + 2] = wq[2]; wp[4 * q + 3] = wq[3]; }
#pragma unroll
            for (int q = 0; q < 4; ++q) {
                o[2 * q] += wp[2 * q] * __uint_as_float(x0[q] << 16); o[2 * q + 1] += wp[2 * q + 1] * __uint_as_float(x0[q] & 0xffff0000u);
                o[8 + 2 * q] += wp[8 + 2 * q] * __uint_as_float(x1[q] << 16); o[8 + 2 * q + 1] += wp[8 + 2 * q + 1] * __uint_as_float(x1[q] & 0xffff0000u);
            }
        }
    }
#pragma unroll
    for (int e = 0; e < 16; ++e) o[e] = silu_f(o[e]);
}

DI void conv16_load(const bf16_t* P, int b, int t, int ch0, u32x4 (&x)[8]) {
#pragma unroll
    for (int j = 0; j < 4; ++j) { const int tt = t - 3 + j; x[2 * j] = (u32x4){0u, 0u, 0u, 0u}; x[2 * j + 1] = (u32x4){0u, 0u, 0u, 0u};
        if (tt >= 0) { const bf16_t* xp = P + ((size_t)b * LT + tt) * NIN + C_X + ch0; x[2 * j] = *(const u32x4*)xp; x[2 * j + 1] = *(const u32x4*)(xp + 8); } }
}
DI void conv16_fin(const u32x4 (&x)[8], int t, int ch0, const float* cw, const float* cb, float (&o)[16]) {
    if (t < 0) {
#pragma unroll
        for (int e = 0; e < 16; ++e) o[e] = 0.f;
        return;
    }
#pragma unroll
    for (int q = 0; q < 4; ++q) { const f32x4 bq = *(const f32x4*)(cb + ch0 + 4 * q); o[4 * q] = bq[0]; o[4 * q + 1] = bq[1]; o[4 * q + 2] = bq[2]; o[4 * q + 3] = bq[3]; }
#pragma unroll
    for (int j = 0; j < 4; ++j) {
        const u32x4 x0 = x[2 * j], x1 = x[2 * j + 1];
        float wp[16];
#pragma unroll
        for (int q = 0; q < 4; ++q) { const f32x4 wq = *(const f32x4*)(cw + j * 1536 + ch0 + 4 * q); wp[4 * q] = wq[0]; wp[4 * q + 1] = wq[1]; wp[4 * q + 2] = wq[2]; wp[4 * q + 3] = wq[3]; }
#pragma unroll
        for (int q = 0; q < 4; ++q) {
            o[2 * q] += wp[2 * q] * __uint_as_float(x0[q] << 16); o[2 * q + 1] += wp[2 * q + 1] * __uint_as_float(x0[q] & 0xffff0000u);
            o[8 + 2 * q] += wp[8 + 2 * q] * __uint_as_float(x1[q] << 16); o[8 + 2 * q + 1] += wp[8 + 2 * q + 1] * __uint_as_float(x1[q] & 0xffff0000u);
        }
    }
#pragma unroll
    for (int e = 0; e < 16; ++e) o[e] = silu_f(o[e]);
}

DI void cumsum_item(LAS unsigned char* lds, const float* FDT, const float* bfg, float* CC, int bh) {
    int tid_ = threadIdx.x; asm volatile("" : "+v"(tid_));
    const int tid = tid_, wid = __builtin_amdgcn_readfirstlane(tid >> 6), lane = tid & 63;
    LAS float* wsum = (LAS float*)lds;
    const int b = bh >> 3, h = bh & 7; const float bias = bfg[h];
    float xv[9];
#pragma unroll
    for (int j = 0; j < 9; ++j) { const int t = tid * 9 + j; xv[j] = t < LT ? FDT[((size_t)b * LT + t) * 32 + h] + bias : 0.f; }
    float s = 0.f;
#pragma unroll
    for (int j = 0; j < 9; ++j) { const int t = tid * 9 + j; const float x = xv[j]; s += t < LT ? fminf(x, 0.f) - __logf(1.f + __expf(-fabsf(x))) : 0.f; xv[j] = s; }
    const float incl = wave_incl_scan(s, lane);
    __syncthreads();
    if (lane == 63) wsum[wid] = incl;
    __syncthreads();
    float off = incl - s;
    for (int w = 0; w < wid; ++w) off += wsum[w];
#pragma unroll
    for (int j = 0; j < 9; ++j) { const int t = tid * 9 + j; if (t < LT) CC[(size_t)bh * LT + t] = off + xv[j]; }
}

DI void chunk_dt(const float* FDT, const float* dt_bias, const float* a_log, int b, int t0, int h, int lane, float& dt0, float& dt1, float& ac0, float& ac1, float& total) {
    const int ta = t0 + 2 * lane, tb = ta + 1;
    const float bias = dt_bias[h], a = -__expf(a_log[h]);
    dt0 = ta >= 0 ? softplus_f(FDT[((size_t)b * LT + ta) * 32 + 8 + h] + bias) : 0.f;
    dt1 = tb >= 0 ? softplus_f(FDT[((size_t)b * LT + tb) * 32 + 8 + h] + bias) : 0.f;
    const float x0 = dt0 * a, x1 = dt1 * a, s = x0 + x1;
    const float incl = wave_incl_scan(s, lane), excl = incl - s;
    ac0 = excl + x0; ac1 = excl + s; total = __uint_as_float(__builtin_amdgcn_readlane(__float_as_uint(incl), 63));
}

DI void ssda_item(int it, LAS unsigned char* lds, const bf16_t* P, const float* FDT, const float* cw, const float* cb, const float* dt_bias, const float* a_log, float* ST, float* CD) {
    int tid_ = threadIdx.x; asm volatile("" : "+v"(tid_));
    const int tid = tid_, wid = __builtin_amdgcn_readfirstlane(tid >> 6), lane = tid & 63, fr = lane & 15, fq = lane >> 4;
    LAS bf16_t* xsT = (LAS bf16_t*)lds;
    LAS bf16_t* BmT = (LAS bf16_t*)(lds + 34816);
    LAS float* wl = (LAS float*)(lds + 69632);
    const int g = it & 1, rest = it >> 1, c = rest % NBLK, b = rest / NBLK, t0 = 128 * c - 112;
    { float dt0, dt1, ac0, ac1, total; chunk_dt(FDT, dt_bias, a_log, b, t0, g * 8 + wid, lane, dt0, dt1, ac0, ac1, total);
      wl[wid * 128 + 2 * lane] = dt0 * __expf(total - ac0); wl[wid * 128 + 2 * lane + 1] = dt1 * __expf(total - ac1);
      if (lane == 63) CD[(b * NBLK + c) * 16 + g * 8 + wid] = __expf(total); }
#pragma unroll
    for (int i = 0; i < 2; ++i) { const int l = (wid & 1) * 64 + lane, cg8 = (wid >> 1) + 4 * i; float o[16]; conv16(P, b, t0 + l, 1024 + g * 128 + cg8 * 16, cw, cb, o);
#pragma unroll
      for (int e = 0; e < 16; ++e) BmT[(cg8 * 16 + e) * 136 + l] = f2bf(o[e]); }
    __syncthreads();
    bf16x8 af[4];
#pragma unroll
    for (int ks = 0; ks < 4; ++ks) af[ks] = *(const LAS bf16x8*)(BmT + (16 * wid + fr) * 136 + ks * 32 + fq * 8);
    u32x4 cxs[8];
    conv16_load(P, b, t0 + (wid & 1) * 64 + lane, g * 8 * 64 + (wid >> 1) * 16, cxs);
    for (int h8 = 0; h8 < 8; ++h8) {
        const int h = g * 8 + h8;
        LAS bf16_t* xb = xsT + (h8 & 1) * (64 * 136);
        { const int l = (wid & 1) * 64 + lane, cg4 = wid >> 1; float o[16]; conv16_fin(cxs, t0 + l, h * 64 + cg4 * 16, cw, cb, o); const float w = wl[h8 * 128 + l];
#pragma unroll
          for (int e = 0; e < 16; ++e) xb[(cg4 * 16 + e) * 136 + l] = f2bf(o[e] * w); }
        if (h8 < 7) conv16_load(P, b, t0 + (wid & 1) * 64 + lane, (h + 1) * 64 + (wid >> 1) * 16, cxs);
        __syncthreads();
        float* stp = ST + ((size_t)((b * NBLK + c) * 16 + h)) * 8192;
#pragma unroll
        for (int mt = 0; mt < 4; ++mt) { f32x4 acc = (f32x4){0.f, 0.f, 0.f, 0.f};
#pragma unroll
            for (int ks = 0; ks < 4; ++ks) { const bf16x8 xf = *(const LAS bf16x8*)(xb + (16 * mt + fr) * 136 + ks * 32 + fq * 8); acc = mfma16(af[ks], xf, acc); }
            *(f32x4*)(stp + (16 * mt + fr) * 128 + 16 * wid + 4 * fq) = acc; }
    }
}

DI void scan_phase(float* ST, const float* CD) {
    int tid_ = threadIdx.x; asm volatile("" : "+v"(tid_));
    for (int e4 = blockIdx.x * NTHR + tid_; e4 < NBATCH * 16 * 64 * 32; e4 += gridDim.x * NTHR) {
        const int n4 = e4 & 31, pp = (e4 >> 5) & 63, h = (e4 >> 11) & 15, b = e4 >> 15;
        f32x4 hs = (f32x4){0.f, 0.f, 0.f, 0.f};
#pragma unroll 11
        for (int c = 0; c < NBLK; ++c) { f32x4* ptr = (f32x4*)(ST + ((size_t)((b * NBLK + c) * 16 + h)) * 8192 + pp * 128 + n4 * 4); const f32x4 s = *ptr; *ptr = hs; const float d = CD[(b * NBLK + c) * 16 + h]; hs = hs * d + s; }
    }
}

DI void ssdc_item(int it, LAS unsigned char* lds, const bf16_t* P, const float* FDT, const float* cw, const float* cb, const float* dt_bias, const float* a_log, const float* d_skip,
                   const float* norm_w, const float* ST, bf16_t* Y) {
    int tid_ = threadIdx.x; asm volatile("" : "+v"(tid_));
    const int tid = tid_, wid = __builtin_amdgcn_readfirstlane(tid >> 6), lane = tid & 63, fr = lane & 15, fq = lane >> 4;
    LAS bf16_t* BmS = (LAS bf16_t*)lds;
    LAS bf16_t* CmS = (LAS bf16_t*)(lds + 34816);
    LAS bf16_t* xsT = (LAS bf16_t*)(lds + 69632);
    LAS bf16_t* prevS = (LAS bf16_t*)(lds + 87040);
    LAS float* dts = (LAS float*)(lds + 104448);
    LAS float* acss = (LAS float*)(lds + 108544);
    {
        const int g = it & 1, rest = it >> 1, c = rest % NBLK, b = rest / NBLK, t0 = 128 * c - 112;
        { float dt0, dt1, ac0, ac1, total; chunk_dt(FDT, dt_bias, a_log, b, t0, g * 8 + wid, lane, dt0, dt1, ac0, ac1, total);
          dts[wid * 128 + 2 * lane] = dt0; dts[wid * 128 + 2 * lane + 1] = dt1; acss[wid * 128 + 2 * lane] = ac0; acss[wid * 128 + 2 * lane + 1] = ac1; }
#pragma unroll
        for (int i = 0; i < 4; ++i) { const int l = (wid & 1) * 64 + lane, cgi = (wid >> 1) + 4 * i; float o[16];
            conv16(P, b, t0 + l, (cgi < 8 ? 1024 : 1280) + g * 128 + (cgi & 7) * 16, cw, cb, o);
            LAS bf16_t* dst = (cgi < 8 ? BmS : CmS) + l * 136 + (cgi & 7) * 16;
            u32x4 w0, w1; w0.x = cvt_pk_bf16(o[0], o[1]); w0.y = cvt_pk_bf16(o[2], o[3]); w0.z = cvt_pk_bf16(o[4], o[5]); w0.w = cvt_pk_bf16(o[6], o[7]);
            w1.x = cvt_pk_bf16(o[8], o[9]); w1.y = cvt_pk_bf16(o[10], o[11]); w1.z = cvt_pk_bf16(o[12], o[13]); w1.w = cvt_pk_bf16(o[14], o[15]);
            *(LAS u32x4*)dst = w0; *(LAS u32x4*)(dst + 8) = w1; }
        __syncthreads();
        bf16x8 cmf[4];
#pragma unroll
        for (int ks = 0; ks < 4; ++ks) cmf[ks] = *(const LAS bf16x8*)(CmS + (16 * wid + fr) * 136 + ks * 32 + fq * 8);
        f32x4 cbt[8];
#pragma unroll
        for (int nt = 0; nt < 8; ++nt) { cbt[nt] = (f32x4){0.f, 0.f, 0.f, 0.f};
            if (nt <= wid) {
#pragma unroll
                for (int ks = 0; ks < 4; ++ks) { const bf16x8 bmf = *(const LAS bf16x8*)(BmS + (16 * nt + fr) * 136 + ks * 32 + fq * 8); cbt[nt] = mfma16(bmf, cmf[ks], cbt[nt]); } } }
        const int li = 16 * wid + fr, t = t0 + li; const bool valid = t >= 0;
        const size_t grow = (size_t)b * LT + (valid ? t : 0);
        float ssq = 0.f;
        f32x4 pvs[4];
        { const float* stp = ST + ((size_t)((b * NBLK + c) * 16 + g * 8)) * 8192;
#pragma unroll
          for (int i = 0; i < 4; ++i) { const int idx = tid + NTHR * i; pvs[i] = *(const f32x4*)(stp + (idx >> 5) * 128 + (idx & 31) * 4); } }
        for (int h8 = 0; h8 < 8; ++h8) {
            const int h = g * 8 + h8;
            __syncthreads();
            { const int l = (wid & 1) * 64 + lane, cg4 = wid >> 1; float o[16]; conv16(P, b, t0 + l, h * 64 + cg4 * 16, cw, cb, o);
#pragma unroll
              for (int e = 0; e < 16; ++e) xsT[(cg4 * 16 + e) * 136 + l] = f2bf(o[e]); }
#pragma unroll
            for (int i = 0; i < 4; ++i) { const int idx = tid + NTHR * i, pp = idx >> 5, n4 = idx & 31; const f32x4 v = pvs[i];
                u32x2 w; w.x = cvt_pk_bf16(v[0], v[1]); w.y = cvt_pk_bf16(v[2], v[3]); *(LAS u32x2*)(prevS + pp * 136 + n4 * 4) = w; }
            u32x2 zw4[4];
#pragma unroll
            for (int pt = 0; pt < 4; ++pt) zw4[pt] = *(const u32x2*)(P + grow * NIN + C_Z + h * 64 + 16 * pt + 4 * fq);
            __syncthreads();
            if (h8 < 7) { const float* stp = ST + ((size_t)((b * NBLK + c) * 16 + h + 1)) * 8192;
#pragma unroll
                for (int i = 0; i < 4; ++i) { const int idx = tid + NTHR * i; pvs[i] = *(const f32x4*)(stp + (idx >> 5) * 128 + (idx & 31) * 4); } }
            const float acl = acss[h8 * 128 + li];
            f32x4 yacc[4], yoff[4];
#pragma unroll
            for (int pt = 0; pt < 4; ++pt) { yacc[pt] = (f32x4){0.f, 0.f, 0.f, 0.f}; yoff[pt] = (f32x4){0.f, 0.f, 0.f, 0.f}; }
#pragma unroll
            for (int ksp = 0; ksp < 4; ++ksp) {
                if (2 * ksp <= wid) {
                    const int s0 = 32 * ksp + 4 * fq, s1 = s0 + 16;
                    const f32x4 as0 = *(const LAS f32x4*)(acss + h8 * 128 + s0), as1 = *(const LAS f32x4*)(acss + h8 * 128 + s1);
                    const f32x4 d0 = *(const LAS f32x4*)(dts + h8 * 128 + s0), d1 = *(const LAS f32x4*)(dts + h8 * 128 + s1);
                    float g0[4], g1[4];
#pragma unroll
                    for (int j = 0; j < 4; ++j) {
                        g0[j] = (s0 + j <= li) ? cbt[2 * ksp][j] * __expf(acl - as0[j]) * d0[j] : 0.f;
                        g1[j] = (s1 + j <= li) ? cbt[2 * ksp + 1][j] * __expf(acl - as1[j]) * d1[j] : 0.f;
                    }
                    u32x4 gw; gw.x = cvt_pk_bf16(g0[0], g0[1]); gw.y = cvt_pk_bf16(g0[2], g0[3]); gw.z = cvt_pk_bf16(g1[0], g1[1]); gw.w = cvt_pk_bf16(g1[2], g1[3]);
                    const bf16x8 gf = __builtin_bit_cast(bf16x8, gw);
#pragma unroll
                    for (int pt = 0; pt < 4; ++pt) {
                        const s16x4 lo = *(const LAS s16x4*)(xsT + (16 * pt + fr) * 136 + s0), hi = *(const LAS s16x4*)(xsT + (16 * pt + fr) * 136 + s1);
                        const bf16x8 xf = __builtin_shufflevector(lo, hi, 0, 1, 2, 3, 4, 5, 6, 7);
                        yacc[pt] = mfma16(xf, gf, yacc[pt]);
                    }
                }
            }
#pragma unroll
            for (int ks = 0; ks < 4; ++ks)
#pragma unroll
                for (int pt = 0; pt < 4; ++pt) { const bf16x8 pf = *(const LAS bf16x8*)(prevS + (16 * pt + fr) * 136 + ks * 32 + fq * 8); yoff[pt] = mfma16(pf, cmf[ks], yoff[pt]); }
            const float eal = __expf(acl), dsk = d_skip[h];
#pragma unroll
            for (int pt = 0; pt < 4; ++pt) {
                const int p0 = 16 * pt + 4 * fq;
                const u32x2 zw = zw4[pt];
                float zz[4] = {__uint_as_float(zw.x << 16), __uint_as_float(zw.x & 0xffff0000u), __uint_as_float(zw.y << 16), __uint_as_float(zw.y & 0xffff0000u)};
                float gy[4];
#pragma unroll
                for (int j = 0; j < 4; ++j) { const float xv = bf2f(xsT[(p0 + j) * 136 + li]); const float y = yacc[pt][j] + eal * yoff[pt][j] + xv * dsk; gy[j] = y * silu_f(zz[j]); ssq += gy[j] * gy[j]; }
                if (valid) { u32x2 w; w.x = cvt_pk_bf16(gy[0], gy[1]); w.y = cvt_pk_bf16(gy[2], gy[3]); *(u32x2*)(Y + grow * D + 1024 + h * 64 + p0) = w; }
            }
        }
        ssq += shx(ssq, 16, lane); ssq += shx(ssq, 32, lane);
        const float rstd = __builtin_amdgcn_rsqf(ssq * (1.f / 512.f) + RMS_EPS);
        if (valid) {
            u32x2 yv[8][4];
#pragma unroll
            for (int h8 = 0; h8 < 8; ++h8)
#pragma unroll
                for (int pt = 0; pt < 4; ++pt) yv[h8][pt] = *(const u32x2*)(Y + grow * D + 1024 + (g * 8 + h8) * 64 + 16 * pt + 4 * fq);
#pragma unroll
            for (int h8 = 0; h8 < 8; ++h8)
#pragma unroll
                for (int pt = 0; pt < 4; ++pt) { const int ch = (g * 8 + h8) * 64 + 16 * pt + 4 * fq; const u32x2 w = yv[h8][pt]; const f32x4 nw = *(const f32x4*)(norm_w + ch);
                    u32x2 o; o.x = cvt_pk_bf16(__uint_as_float(w.x << 16) * rstd * nw[0], __uint_as_float(w.x & 0xffff0000u) * rstd * nw[1]);
                    o.y = cvt_pk_bf16(__uint_as_float(w.y << 16) * rstd * nw[2], __uint_as_float(w.y & 0xffff0000u) * rstd * nw[3]); *(u32x2*)(Y + grow * D + 1024 + ch) = o; }
        }
    }
}

DI void pool_item(int it, LAS unsigned char* lds, const bf16_t* P, const bf16_t* PWT, const float* pscale, bf16_t* Y) {
    int tid_ = threadIdx.x; asm volatile("" : "+v"(tid_));
    const int tid = tid_, wid = __builtin_amdgcn_readfirstlane(tid >> 6), lane = tid & 63, fr = lane & 15, fq = lane >> 4;
    LAS bf16_t* Us = (LAS bf16_t*)lds;
    LAS bf16_t* Xs = (LAS bf16_t*)(lds + 36608);
    LAS bf16_t* Ws = (LAS bf16_t*)(lds + 36608 + 34816);
    {
        const int g = it & 3, rest = it >> 2, blk = rest % NBLK, b = rest / NBLK, t0 = 128 * blk - 112;
        for (int cidx = tid; cidx < 143 * 16; cidx += NTHR) { const int j = cidx >> 4, ch = cidx & 15, t = t0 - 15 + j;
            u32x4 v = (u32x4){0u, 0u, 0u, 0u}; if (t >= 0) v = *(const u32x4*)(P + ((size_t)b * LT + t) * NIN + C_U + g * 128 + ch * 8);
            *(LAS u32x4*)(Us + j * 128 + ch * 8) = v; }
        for (int cidx = tid; cidx < 128 * 16; cidx += NTHR) { const int d = cidx >> 4, ch = cidx & 15; *(LAS u32x4*)(Ws + d * 136 + ch * 8) = *(const u32x4*)(PWT + (size_t)(g * 128 + d) * 128 + ch * 8); }
        __syncthreads();
        { const int cch = tid & 127, w = 2 << g, i0 = (tid >> 7) * 32;
          float s = 0.f;
          for (int j = 1; j < w; ++j) s += bf2f(Us[(i0 + 15 - j) * 128 + cch]);
          for (int k = 0; k < 32; ++k) { const int i = i0 + k, t = t0 + i;
              const float ucur = bf2f(Us[(i + 15) * 128 + cch]); s += ucur;
              const int cnt = t + 1 < w ? (t + 1 < 1 ? 1 : t + 1) : w;
              Xs[i * 136 + cch] = f2bf(s / (float)cnt - ucur);
              s -= bf2f(Us[(i + 15 - (w - 1)) * 128 + cch]); } }
        __syncthreads();
        bf16x8 xf[4];
#pragma unroll
        for (int ks = 0; ks < 4; ++ks) xf[ks] = *(const LAS bf16x8*)(Xs + (16 * wid + fr) * 136 + ks * 32 + fq * 8);
        const int t = t0 + 16 * wid + fr;
#pragma unroll
        for (int nt = 0; nt < 8; ++nt) { f32x4 acc = (f32x4){0.f, 0.f, 0.f, 0.f};
#pragma unroll
            for (int ks = 0; ks < 4; ++ks) { const bf16x8 wf = *(const LAS bf16x8*)(Ws + (16 * nt + fr) * 136 + ks * 32 + fq * 8); acc = mfma16(wf, xf[ks], acc); }
            if (t >= 0) { const int d0 = 16 * nt + 4 * fq; const f32x4 sc = *(const f32x4*)(pscale + g * 128 + d0);
                u32x2 w; w.x = cvt_pk_bf16(acc[0] * sc[0], acc[1] * sc[1]); w.y = cvt_pk_bf16(acc[2] * sc[2], acc[3] * sc[3]);
                *(u32x2*)(Y + ((size_t)b * LT + t) * D + 512 + g * 128 + d0) = w; } }
    }
}

DI void attn_item(int it, LAS unsigned char* lds, const bf16_t* P, const float* CC, bf16_t* Y) {
    int tid_ = threadIdx.x; asm volatile("" : "+v"(tid_));
    const int tid = tid_, wid = __builtin_amdgcn_readfirstlane(tid >> 6), lane = tid & 63, fr = lane & 15, fq = lane >> 4;
    LAS bf16_t* Ks = (LAS bf16_t*)lds;
    LAS bf16_t* Vt = (LAS bf16_t*)(lds + 18432);
    LAS float* cks = (LAS float*)(lds + 18432 + 17408);
    {
        const int jp = 16 - (it >> 5), bh = it & 31;
        const int b = bh >> 3, h = bh & 7;
        const size_t rowb = (size_t)b * LT;
        const int qi = 16 * wid + fr;
        int qbs[2]; qbs[0] = 2 * jp; qbs[1] = 2 * jp + 1 <= 32 ? 2 * jp + 1 : -1;
        const int ktmax = qbs[1] >= 0 ? qbs[1] : qbs[0];
        bf16x8 qf[2][2]; float cq[2]; bool qvalid[2]; size_t qrow[2];
        f32x4 oacc[2][4]; float mrun[2], lsum[2];
#pragma unroll
        for (int qq = 0; qq < 2; ++qq) {
            const int tq = 128 * qbs[qq] - 112 + qi; qvalid[qq] = (qbs[qq] >= 0) && (tq >= 0);
            qrow[qq] = rowb + (qvalid[qq] ? tq : 0);
            const bf16_t* qp = P + qrow[qq] * NIN + C_Q + h * 64 + fq * 8;
#pragma unroll
            for (int ks = 0; ks < 2; ++ks) { const u32x4 qw = *(const u32x4*)(qp + 32 * ks); u32x4 qs;
#pragma unroll
                for (int e = 0; e < 4; ++e) qs[e] = cvt_pk_bf16(__uint_as_float(qw[e] << 16) * 0.125f, __uint_as_float(qw[e] & 0xffff0000u) * 0.125f);
                qf[qq][ks] = __builtin_bit_cast(bf16x8, qs); }
            cq[qq] = CC[(size_t)bh * LT + (qvalid[qq] ? tq : 0)];
#pragma unroll
            for (int mt = 0; mt < 4; ++mt) oacc[qq][mt] = (f32x4){0.f, 0.f, 0.f, 0.f};
            mrun[qq] = -1e30f; lsum[qq] = 0.f;
        }
        u32x4 kreg[2], vreg[2]; float creg = 0.f;
#define ATT_PREFETCH(kt_) do { const int tb_ = 128 * (kt_) - 112; \
        _Pragma("unroll") for (int i_ = 0; i_ < 2; ++i_) { const int c_ = tid + NTHR * i_; \
            { const int key_ = c_ >> 3, dch_ = c_ & 7, t_ = tb_ + key_; kreg[i_] = (u32x4){0u, 0u, 0u, 0u}; if (t_ >= 0) kreg[i_] = *(const u32x4*)(P + (rowb + t_) * NIN + C_K + h * 64 + dch_ * 8); } \
            { const int key_ = c_ >> 3, dch_ = c_ & 7, t_ = tb_ + key_; vreg[i_] = (u32x4){0u, 0u, 0u, 0u}; if (t_ >= 0) vreg[i_] = *(const u32x4*)(P + (rowb + t_) * NIN + C_V + h * 64 + dch_ * 8); } } \
        if (tid < 128) { const int t_ = tb_ + tid; creg = t_ >= 0 ? CC[(size_t)bh * LT + t_] : 0.f; } } while (0)
        ATT_PREFETCH(0);
        for (int kt = 0; kt <= ktmax; ++kt) {
            __syncthreads();
#pragma unroll
            for (int i = 0; i < 2; ++i) { const int cidx = tid + NTHR * i;
                { const int key = cidx >> 3, dch = cidx & 7; *(LAS u32x4*)(Ks + key * 72 + dch * 8) = kreg[i]; }
                { const int key = cidx >> 3, dch = cidx & 7, kx = key ^ (4 * dch);
#pragma unroll
                  for (int q = 0; q < 4; ++q) { Vt[(dch * 8 + 2 * q) * 136 + kx] = (bf16_t)(vreg[i][q] & 0xffffu); Vt[(dch * 8 + 2 * q + 1) * 136 + kx] = (bf16_t)(vreg[i][q] >> 16); } } }
            if (tid < 128) cks[tid] = creg;
            __syncthreads();
            if (kt < ktmax) ATT_PREFETCH(kt + 1);
            const bool act0 = kt <= qbs[0], act1 = kt <= qbs[1];
            f32x4 sc[2][8];
#pragma unroll
            for (int nt = 0; nt < 8; ++nt) { const f32x4 ck = *(const LAS f32x4*)(cks + 16 * nt + 4 * fq);
                const bf16x8 kf0 = *(const LAS bf16x8*)(Ks + (16 * nt + fr) * 72 + fq * 8), kf1 = *(const LAS bf16x8*)(Ks + (16 * nt + fr) * 72 + 32 + fq * 8);
                if (act0) { f32x4 s = cq[0] - ck; s = mfma16(kf0, qf[0][0], s); s = mfma16(kf1, qf[0][1], s); sc[0][nt] = s; }
                if (act1) { f32x4 s = cq[1] - ck; s = mfma16(kf0, qf[1][0], s); s = mfma16(kf1, qf[1][1], s); sc[1][nt] = s; } }
            bf16x8 pf[2][4];
#pragma unroll
            for (int qq = 0; qq < 2; ++qq) {
                if (qq == 0 ? act0 : act1) {
                    const int qb = qbs[qq];
                    if (kt == 0 || kt == qb) {
#pragma unroll
                        for (int nt = 0; nt < 8; ++nt)
#pragma unroll
                            for (int j = 0; j < 4; ++j) { const int sl = 16 * nt + 4 * fq + j; const bool ok = (kt > 0 || sl >= 112) && (kt < qb || sl <= qi); sc[qq][nt][j] = ok ? sc[qq][nt][j] : -1e30f; }
                    }
                    float mloc = -1e30f;
#pragma unroll
                    for (int nt = 0; nt < 8; ++nt) mloc = fmaxf(mloc, fmaxf(fmaxf(sc[qq][nt][0], sc[qq][nt][1]), fmaxf(sc[qq][nt][2], sc[qq][nt][3])));
                    mloc = fmaxf(mloc, shx(mloc, 16, lane)); mloc = fmaxf(mloc, shx(mloc, 32, lane));
                    const float mnew = fmaxf(mrun[qq], mloc), alpha = __builtin_amdgcn_exp2f((mrun[qq] - mnew) * LOG2E), mneg = -mnew * LOG2E; mrun[qq] = mnew;
                    float psum = 0.f;
#pragma unroll
                    for (int nt = 0; nt < 8; ++nt)
#pragma unroll
                        for (int j = 0; j < 4; ++j) { const float pv = __builtin_amdgcn_exp2f(__builtin_fmaf(sc[qq][nt][j], LOG2E, mneg)); sc[qq][nt][j] = pv; psum += pv; }
                    lsum[qq] = lsum[qq] * alpha + psum;
#pragma unroll
                    for (int mt = 0; mt < 4; ++mt) oacc[qq][mt] = oacc[qq][mt] * alpha;
#pragma unroll
                    for (int s4 = 0; s4 < 4; ++s4) {
                        u32x4 pw; pw.x = cvt_pk_bf16(sc[qq][2 * s4][0], sc[qq][2 * s4][1]); pw.y = cvt_pk_bf16(sc[qq][2 * s4][2], sc[qq][2 * s4][3]); pw.z = cvt_pk_bf16(sc[qq][2 * s4 + 1][0], sc[qq][2 * s4 + 1][1]); pw.w = cvt_pk_bf16(sc[qq][2 * s4 + 1][2], sc[qq][2 * s4 + 1][3]);
                        pf[qq][s4] = __builtin_bit_cast(bf16x8, pw); }
                }
            }
#pragma unroll
            for (int s4 = 0; s4 < 4; ++s4)
#pragma unroll
                for (int mt = 0; mt < 4; ++mt) {
                    const int vsw = 4 * (2 * mt + (fr >> 3));
                    const s16x4 lo = *(const LAS s16x4*)(Vt + (16 * mt + fr) * 136 + ((32 * s4 + 4 * fq) ^ vsw)), hi = *(const LAS s16x4*)(Vt + (16 * mt + fr) * 136 + ((32 * s4 + 16 + 4 * fq) ^ vsw));
                    const bf16x8 vf = __builtin_shufflevector(lo, hi, 0, 1, 2, 3, 4, 5, 6, 7);
                    if (act0) oacc[0][mt] = mfma16(vf, pf[0][s4], oacc[0][mt]);
                    if (act1) oacc[1][mt] = mfma16(vf, pf[1][s4], oacc[1][mt]);
                }
        }
#undef ATT_PREFETCH
#pragma unroll
        for (int qq = 0; qq < 2; ++qq) {
            float ls = lsum[qq]; ls += shx(ls, 16, lane); ls += shx(ls, 32, lane);
            const float inv = 1.f / ls;
            if (qvalid[qq]) {
#pragma unroll
                for (int mt = 0; mt < 4; ++mt) { u32x2 w; w.x = cvt_pk_bf16(oacc[qq][mt][0] * inv, oacc[qq][mt][1] * inv); w.y = cvt_pk_bf16(oacc[qq][mt][2] * inv, oacc[qq][mt][3] * inv);
                    *(u32x2*)(Y + qrow[qq] * D + h * 64 + 16 * mt + 4 * fq) = w; }
            }
        }
    }
}

#define XB_TMO      128
#define XB_XCNT(j)  (256  + 64 * (j))
#define XB_XSUB(j)  (1280 + 64 * (j))
#define XB_XGEN(j)  (2304 + 64 * (j))
#define XB_TOP      3328
#define XB_TOPGEN   3392
#define XB_SPIN_CAP (1u << 20)
DI unsigned xb_ld(unsigned* p)              { return __hip_atomic_load(p, __ATOMIC_RELAXED, __HIP_MEMORY_SCOPE_AGENT); }
DI unsigned xb_add(unsigned* p, unsigned v) { return __hip_atomic_fetch_add(p, v, __ATOMIC_RELAXED, __HIP_MEMORY_SCOPE_AGENT); }
DI unsigned xb_xcc_id() { return (unsigned)__builtin_amdgcn_s_getreg((3 << 11) | 20) & 0xFu; }
#define XB_SPIN(cond, bar) do { unsigned _sp = 0; while (cond) { __builtin_amdgcn_s_sleep(1); \
    if ((++_sp & 255u) == 0u) { if (xb_ld(&(bar)[XB_TMO])) break; if (_sp > XB_SPIN_CAP) { atomicAdd(&(bar)[XB_TMO], 1u); break; } } } } while (0)
struct XcdBarrier { unsigned* bar; unsigned x; volatile LAS unsigned* st; };
DI XcdBarrier xcd_barrier_post(unsigned* bar, volatile LAS unsigned* st) {
    XcdBarrier b; b.bar = bar; b.x = xb_xcc_id(); b.st = st;
    if (threadIdx.x == 0) (void)xb_add(&bar[XB_XCNT(b.x)], 1u);
    return b;
}
DI void xcd_barrier_complete(unsigned* bar, unsigned x, unsigned& nloc, unsigned& nx) {
    const unsigned G = gridDim.x * gridDim.y * gridDim.z;
    unsigned sum, cnt, mine, sp = 0u;
    for (;;) {
        sum = 0u; cnt = 0u; mine = 0u;
#pragma unroll
        for (unsigned j = 0; j < 16; ++j) { const unsigned c = xb_ld(&bar[XB_XCNT(j)]); sum += c; cnt += (c > 0u) ? 1u : 0u; mine = (j == x) ? c : mine; }
        if (sum == G) break;
        __builtin_amdgcn_s_sleep(1);
        if ((++sp & 255u) == 0u) { if (xb_ld(&bar[XB_TMO])) break; if (sp > XB_SPIN_CAP) { atomicAdd(&bar[XB_TMO], 1u); break; } }
    }
    nloc = mine > 0u ? mine : 1u; nx = cnt > 0u ? cnt : 1u;
}
DI void xcd_barrier(const XcdBarrier& b) {
    asm volatile("s_waitcnt vmcnt(0)" ::: "memory");
    __syncthreads();
    if (threadIdx.x == 0) {
        unsigned* bar = b.bar;
        __builtin_amdgcn_s_waitcnt(0);
        unsigned nloc = b.st[0], nx = b.st[1];
        if (nloc == 0u) { xcd_barrier_complete(bar, b.x, nloc, nx); b.st[0] = nloc; b.st[1] = nx; }
        const unsigned old = xb_add(&bar[XB_XSUB(b.x)], 1u);
        const unsigned gen = old / nloc;
        if (old + 1u == (gen + 1u) * nloc) {
            __builtin_amdgcn_fence(__ATOMIC_RELEASE, "agent");
            asm volatile("s_waitcnt vmcnt(0)" ::: "memory");
            const unsigned og = xb_add(&bar[XB_TOP], 1u);
            const unsigned tg = og / nx;
            if (og + 1u == (tg + 1u) * nx) xb_add(&bar[XB_TOPGEN], 1u);
            else XB_SPIN(xb_ld(&bar[XB_TOPGEN]) == tg, bar);
            __builtin_amdgcn_fence(__ATOMIC_ACQUIRE, "agent");
            xb_add(&bar[XB_XGEN(b.x)], 1u);
            asm volatile("s_waitcnt vmcnt(0)" ::: "memory");
        } else {
            XB_SPIN(xb_ld(&bar[XB_XGEN(b.x)]) == gen, bar);
            __builtin_amdgcn_fence(__ATOMIC_ACQUIRE, "agent");
            asm volatile("s_waitcnt vmcnt(0)" ::: "memory");
        }
    }
    __syncthreads();
}

constexpr int NSTEP_L = 9, NPHASE = 1 + NSTEP_L * DEPTH + 1;

__global__ void __launch_bounds__(NTHR) mega(Params p) {
    extern __shared__ __attribute__((aligned(16))) unsigned char lds_raw[];
    LAS unsigned char* lds = (LAS unsigned char*)lds_raw;
    cg::grid_group grid = cg::this_grid();
    LAS unsigned* stw = (LAS unsigned*)(lds + LDS_BYTES - 32);
    if (threadIdx.x == 0) { stw[0] = 0u; stw[1] = 0u; }
    __syncthreads();
    const XcdBarrier xb = xcd_barrier_post((unsigned*)(p.ws + WS_BAR), (volatile LAS unsigned*)stw);
    for (int ph = p.ph_lo; ph < p.ph_hi; ++ph) {
        if (p.ph_lo < 0) grid.sync();
        if (ph > p.ph_lo) xcd_barrier(xb);
        size_t zoff = 0; asm volatile("" : "+s"(zoff));
        unsigned char* ws = p.ws + zoff;
        float* H32 = (float*)(ws + WS_H32); bf16_t* H16 = (bf16_t*)(ws + WS_H16); float* ST = (float*)(ws + WS_H16);
        bf16_t* ACT = (bf16_t*)(ws + WS_BIG); bf16_t* PROJ = (bf16_t*)(ws + WS_BIG); bf16_t* Y = (bf16_t*)(ws + WS_BIG + SZ_PROJ);
        float* FDT = (float*)(ws + WS_FDT); float* CC = (float*)(ws + WS_CC); float* CD = (float*)(ws + WS_CD);
        float* STAT = (float*)(ws + WS_STAT);
        if (ph == 0) { prep_phase(lds, p); continue; }
        if (ph == NPHASE - 1) { ln_phase(H32, H16, p.in[23] + (DEPTH - 1) * D, p.in[24] + (DEPTH - 1) * D, p.out); continue; }
        const int l = (ph - 1) / NSTEP_L, s = (ph - 1) % NSTEP_L;
#ifdef REP_S
        for (int rep = 0; rep < ((s == REP_S) ? 2 : 1); ++rep) {
        if (rep) xcd_barrier(xb);
#else
        { const int rep = 0; (void)rep;
#endif
        switch (s) {
        case 0: case 7: {
            const int f = (s == 7), q = l * 2 + f, stg = 3 * l + 2 * f;
            const float* st = stg ? STAT + (size_t)stg * R * 2 : nullptr;
            const bf16_t* Wt = (const bf16_t*)(ws + WS_WGU + (size_t)q * SZ_WGU);
            const float* GW = (const float*)(ws + WS_GWGU) + (size_t)q * 2 * FF; const float* BW = (const float*)(ws + WS_BWGU) + (size_t)q * 2 * FF;
            pg8::Gemm g{H16, Wt, 2 * FF, D}; pg8::StaticOrder S; S.init(2 * FF, gridDim.x, blockIdx.x);
            pg8::EpiGU E{ACT, st, GW, BW};
            pg8::gemm_phase<pg8::EpiGU>(lds, g, S, E);
            skinny_phase<0>(lds, H16, D, Wt, FF / 16, ACT, nullptr, 0.f, st, GW, BW, nullptr, nullptr, nullptr, nullptr);
        } break;
        case 1: case 8: {
            const int f = (s == 8), q = l * 2 + f, stg = 3 * l + 2 * f;
            const float* st = stg ? STAT + (size_t)stg * R * 2 : nullptr;
            const float* lg = f ? p.in[18] + l * D : (l ? p.in[23] + (l - 1) * D : nullptr);
            const float* lb = f ? p.in[19] + l * D : (l ? p.in[24] + (l - 1) * D : nullptr);
            float* sto = STAT + (size_t)(stg + 1) * R * 2;
            const bf16_t* Wt = (const bf16_t*)(ws + WS_WDN + (size_t)q * SZ_WDN);
            pg8::Gemm g{ACT, Wt, D, FF}; pg8::StaticOrder S; S.init(D, gridDim.x, blockIdx.x);
            pg8::EpiRes<true> E{H32, H16, st, lg, lb, sto};
            pg8::gemm_phase<pg8::EpiRes<true>>(lds, g, S, E);
            skinny_phase<1>(lds, ACT, FF, Wt, D / 32, nullptr, H32, 0.5f, st, nullptr, nullptr, lg, lb, sto, H16);
        } break;
        case 2: {
            const float* st = STAT + (size_t)(3 * l + 1) * R * 2;
            const bf16_t* Wt = (const bf16_t*)(ws + WS_WIN + (size_t)l * SZ_WIN);
            const float* GW = (const float*)(ws + WS_GWIN) + (size_t)l * NIN; const float* BW = (const float*)(ws + WS_BWIN) + (size_t)l * NIN;
            pg8::Gemm g{H16, Wt, NIN, D}; pg8::StaticOrder S; S.init(NIN, gridDim.x, blockIdx.x);
            pg8::EpiWin E{PROJ, FDT, st, GW, BW};
            pg8::gemm_phase<pg8::EpiWin>(lds, g, S, E);
            skinny_phase<2>(lds, H16, D, Wt, NIN / 32, PROJ, FDT, 0.f, st, GW, BW, nullptr, nullptr, nullptr, nullptr);
        } break;
        case 3: {
            unsigned* ctr = (unsigned*)(ws + WS_Q) + ph + 32 * rep;
            LAS int* slot = (LAS int*)(lds + LDS_BYTES - 16);
            for (;;) {
                __syncthreads();
                if (threadIdx.x == 0) *slot = (int)atomicAdd(ctr, 1u);
                __syncthreads();
                const int it = *slot;
                constexpr int NSA = NBATCH * NBLK * 2, NPL = NBATCH * NBLK * 4;
                if (it >= NSA + NPL + 32) break;
                if (it < NSA) ssda_item(it, lds, PROJ, FDT, p.in[11] + l * 4 * 1536, p.in[12] + l * 1536, p.in[13] + l * 16, p.in[14] + l * 16, ST, CD);
                else if (it < NSA + NPL) pool_item(it - NSA, lds, PROJ, (const bf16_t*)(ws + WS_PWT) + (size_t)l * 4 * 128 * 128, p.in[10] + l * 512, Y);
                else cumsum_item(lds, FDT, p.in[8] + l * 8, CC, it - NSA - NPL);
            }
        } break;
        case 4:
            scan_phase(ST, CD);
            break;
        case 5: {
            unsigned* ctr = (unsigned*)(ws + WS_Q) + ph + 32 * rep;
            LAS int* slot = (LAS int*)(lds + LDS_BYTES - 16);
            for (;;) {
                __syncthreads();
                if (threadIdx.x == 0) *slot = (int)atomicAdd(ctr, 1u);
                __syncthreads();
                const int it = *slot;
                constexpr int NSC = NBATCH * NBLK * 2, NAT = 32 * 17;
                if (it >= NSC + NAT) break;
                if (it < NSC) ssdc_item(it, lds, PROJ, FDT, p.in[11] + l * 4 * 1536, p.in[12] + l * 1536, p.in[13] + l * 16, p.in[14] + l * 16, p.in[15] + l * 16, p.in[16] + l * 1024, ST, Y);
                else attn_item(it - NSC, lds, PROJ, CC, Y);
            }
        } break;
        case 6: {
            const float* st = STAT + (size_t)(3 * l + 1) * R * 2; float* sto = STAT + (size_t)(3 * l + 2) * R * 2;
            const bf16_t* Wt = (const bf16_t*)(ws + WS_WOUT + (size_t)l * SZ_WOUT);
            pg8::Gemm g{Y, Wt, D, D}; pg8::StaticOrder S; S.init(D, gridDim.x, blockIdx.x);
            pg8::EpiRes<false> E{H32, H16, st, p.in[5] + l * D, p.in[6] + l * D, sto};
            pg8::gemm_phase<pg8::EpiRes<false>>(lds, g, S, E);
            skinny_phase<1>(lds, Y, D, Wt, D / 32, nullptr, H32, 1.0f, st, nullptr, nullptr, p.in[5] + l * D, p.in[6] + l * D, sto, H16);
        } break;
        }
        }
    }
}

extern "C" void kernel_launch(void* const* d_in, const int* in_sizes, int n_in, void* d_out, int out_size, void* d_ws, size_t ws_size, hipStream_t stream) {
    static int grid = 0;
    if (grid == 0) {
        if (n_in != 25 || ws_size < WS_END) { fprintf(stderr, "kernel_launch: need 25 inputs and %zu bytes of workspace (got %d, %zu)\n", (size_t)WS_END, n_in, ws_size); grid = -1; return; }
        int dev = 0, cus = 0, per_cu = 0;
        (void)hipGetDevice(&dev);
        (void)hipDeviceGetAttribute(&cus, hipDeviceAttributeMultiprocessorCount, dev);
        if (hipFuncSetAttribute((const void*)mega, hipFuncAttributeMaxDynamicSharedMemorySize, LDS_BYTES) != hipSuccess) fprintf(stderr, "kernel_launch: hipFuncSetAttribute failed\n");
        if (hipOccupancyMaxActiveBlocksPerMultiprocessor(&per_cu, (const void*)mega, NTHR, LDS_BYTES) != hipSuccess || per_cu < 1) { fprintf(stderr, "kernel_launch: occupancy query says %d\n", per_cu); per_cu = 1; }
        (void)hipGetLastError();
        grid = cus * per_cu;
        if (grid != 256) { fprintf(stderr, "kernel_launch: this build's per-phase folded-LN tables assume a 256-workgroup grid (one per CU of a 256-CU device); got %d\n", grid); grid = -1; return; }
    }
    if (grid < 0) return;
    (void)hipMemsetAsync((unsigned char*)d_ws + WS_ZERO, 0, ZERO_BYTES, stream);
    Params p{};
    for (int i = 0; i < 25; ++i) p.in[i] = (const float*)d_in[i];
    p.out = (float*)d_out; p.ws = (unsigned char*)d_ws;
#if PER_PHASE_LAUNCH
    for (int ph = 0; ph < NPHASE; ++ph) { p.ph_lo = ph; p.ph_hi = ph + 1; hipLaunchKernelGGL(mega, dim3(grid), dim3(NTHR), LDS_BYTES, stream, p); }
#else
    p.ph_lo = 0; p.ph_hi = NPHASE;
    void* args[] = {&p};
    hipError_t e = hipLaunchCooperativeKernel((const void*)mega, dim3(grid), dim3(NTHR), args, LDS_BYTES, stream);
    if (e != hipSuccess) fprintf(stderr, "cooperative launch failed: %s (grid %d)\n", hipGetErrorString(e), grid);
#endif
}
```
